# Optimizing an MI355X kernel written in HIP

```python
import math
import jax
import jax.numpy as jnp
from jax import lax
import numpy as np

D_MODEL = 2048
BATCH = 1
SEQ = 8192
DEPTH = 1
DEC_BATCH = 32
DEC_SEQ = 4
PAST_LEN = 16384
PAGE_SIZE = 128

D_MIX = D_MODEL
D_ATTN = D_MIX // 2
D_CHUNK = D_MIX - D_ATTN
HEAD_DIM = 64
N_HEADS_A = D_ATTN // HEAD_DIM
CHUNK = 128
GROUP_WIDTH_B = 128
N_GROUPS_B = D_CHUNK // GROUP_WIDTH_B
DILATIONS = ((128, 1), (512, 4), (2048, 16))
MAX_WINDOW = 2048
BLOCK = 128
ROPE_THETA = 10000.0
EPS = 1e-6
NEG_INF = -1e30
SPLITS = (D_ATTN, 2 * D_ATTN, 3 * D_ATTN, 4 * D_ATTN, 4 * D_ATTN + D_CHUNK, 4 * D_ATTN + 2 * D_CHUNK)
D_IN = 4 * D_ATTN + 3 * D_CHUNK

kernel_name = 'hybrid_dilated_attn_chunk_gmlp_step'


def _rms_norm(x, g):
    xf = x.astype(jnp.float32)
    y = xf * lax.rsqrt(jnp.mean(xf * xf, axis=-1, keepdims=True) + EPS)
    return (y * g.astype(jnp.float32)).astype(x.dtype)


def _layer_norm(x, g, b):
    xf = x.astype(jnp.float32)
    mu = jnp.mean(xf, axis=-1, keepdims=True)
    var = jnp.mean(jnp.square(xf - mu), axis=-1, keepdims=True)
    y = (xf - mu) * lax.rsqrt(var + EPS)
    return (y * g.astype(jnp.float32) + b.astype(jnp.float32)).astype(x.dtype)


def _rope(x, pos):
    half = HEAD_DIM // 2
    inv = jnp.exp(-math.log(ROPE_THETA) * jnp.arange(half, dtype=jnp.float32) / half)
    ang = pos.astype(jnp.float32)[:, None] * inv[None, :]
    cos = jnp.cos(ang)[None, :, None, :]
    sin = jnp.sin(ang)[None, :, None, :]
    xf = x.astype(jnp.float32)
    x1, x2 = xf[..., :half], xf[..., half:]
    return jnp.concatenate([x1 * cos - x2 * sin, x2 * cos + x1 * sin], axis=-1).astype(x.dtype)


def _branch_inputs(x, pos, norm_g, w_in, ln_g, ln_b):
    B, T, _ = x.shape
    z = _rms_norm(x, norm_g) @ w_in
    q, k, v, ga, u, vc, gb = jnp.split(z, SPLITS, axis=-1)
    hs = (B, T, N_HEADS_A, HEAD_DIM)
    q = _rope(q.reshape(hs), pos)
    k = _rope(k.reshape(hs), pos)
    v = v.reshape(hs)
    u = jax.nn.gelu(u)
    vc = _layer_norm(jax.nn.gelu(vc), ln_g, ln_b)
    return q, k, v, ga, u, vc, gb


def _softmax_lse(s, mask):
    s = jnp.where(mask, s, NEG_INF)
    m = jnp.max(s, axis=-1, keepdims=True)
    p = jnp.exp(s - m)
    den = jnp.sum(p, axis=-1, keepdims=True)
    return p / den, (m + jnp.log(den))[..., 0]


def _combine(outs, lses):
    w = jax.nn.softmax(jnp.stack(lses, axis=0), axis=0)
    return jnp.sum(w[..., None] * jnp.stack(outs, axis=0), axis=0)


def _dilated_attention_prompt(q, k, v):
    B, S, H, hd = q.shape
    scale = HEAD_DIM ** -0.5
    qi = jnp.arange(BLOCK)[:, None]
    si = jnp.arange(2 * BLOCK)[None, :]
    dist = qi + BLOCK - si
    outs, lses = [], []
    for window, d in DILATIONS:
        span = window // d
        L = S // d
        nb = -(-L // BLOCK)
        Lp = nb * BLOCK

        def to_res(a):
            a = a.reshape(B, L, d, H, hd).transpose(0, 2, 1, 3, 4)
            a = jnp.pad(a, ((0, 0), (0, 0), (0, Lp - L), (0, 0), (0, 0)))
            return a.reshape(B, d, nb, BLOCK, H, hd).astype(jnp.float32)

        qb, kb, vb = to_res(q), to_res(k), to_res(v)
        pad_prev = ((0, 0), (0, 0), (1, 0), (0, 0), (0, 0), (0, 0))
        kcat = jnp.concatenate([jnp.pad(kb, pad_prev)[:, :, :nb], kb], axis=3)
        vcat = jnp.concatenate([jnp.pad(vb, pad_prev)[:, :, :nb], vb], axis=3)
        s = jnp.einsum('brnqhk,brnshk->brnhqs', qb, kcat) * scale
        band = (dist >= 0) & (dist <= span)
        has_prev = (jnp.arange(nb) > 0)[:, None, None] | (si >= BLOCK)[None]
        mask = (band[None] & has_prev)[None, None, :, None]
        p, lse = _softmax_lse(s, mask)
        o = jnp.einsum('brnhqs,brnshk->brnqhk', p, vcat)
        o = o.reshape(B, d, Lp, H, hd)[:, :, :L].transpose(0, 2, 1, 3, 4).reshape(B, S, H, hd)
        lse = lse.transpose(0, 1, 2, 4, 3).reshape(B, d, Lp, H)[:, :, :L].transpose(0, 2, 1, 3).reshape(B, S, H)
        outs.append(o)
        lses.append(lse)
    return _combine(outs, lses)


def _dilated_attention_sample(q, k_all, v_all, wb):
    T = q.shape[1]
    scale = HEAD_DIM ** -0.5
    qf = q.astype(jnp.float32)
    outs, lses = [], []
    for window, d in DILATIONS:
        J = window // d + 1
        idx = wb + jnp.arange(T)[:, None] - jnp.arange(J)[None, :] * d
        valid = idx >= 0
        idxc = jnp.maximum(idx, 0)
        kg = k_all[:, idxc].astype(jnp.float32)
        vg = v_all[:, idxc].astype(jnp.float32)
        s = jnp.einsum('bthk,btjhk->bthj', qf, kg) * scale
        p, lse = _softmax_lse(s, valid[None, :, None, :])
        outs.append(jnp.einsum('bthj,btjhk->bthk', p, vg))
        lses.append(lse)
    return _combine(outs, lses)


def _masked_spatial(w_s):
    return w_s * jnp.tril(jnp.ones((CHUNK, CHUNK), w_s.dtype))[None]


def _chunk_mlp_prompt(u, vc, w_s, b_s):
    B, S, _ = u.shape
    vr = vc.reshape(B, S // CHUNK, CHUNK, N_GROUPS_B, GROUP_WIDTH_B)
    mixed = jnp.einsum('gts,bcsgk->bctgk', _masked_spatial(w_s), vr) + jnp.transpose(b_s)[:, :, None]
    return u * mixed.reshape(B, S, D_CHUNK)


def _chunk_mlp_sample(u, vc, w_s, b_s):
    B, T, _ = u.shape
    vr = vc.reshape(B, T, N_GROUPS_B, GROUP_WIDTH_B)
    wm = _masked_spatial(w_s)[:, :T, :T]
    mixed = jnp.einsum('gts,bsgk->btgk', wm, vr) + jnp.transpose(b_s[:, :T])[:, :, None]
    return u * mixed.reshape(B, T, D_CHUNK)


def _output(o_attn, ga, o_chunk, gb, x, w_out):
    B, T, _ = x.shape
    a = o_attn.reshape(B, T, D_ATTN).astype(x.dtype) * jax.nn.silu(ga)
    c = o_chunk * jax.nn.silu(gb)
    return x + jnp.concatenate([a, c], axis=-1) @ w_out


def setup_inputs(seed: int = 0) -> dict:
    key = jax.random.key(seed)
    ks = jax.random.split(key, 14)
    wb = min(MAX_WINDOW, PAST_LEN)
    nrm = jax.random.normal
    f32 = jnp.float32
    return {
        'x_prompt': nrm(ks[0], (BATCH, SEQ, D_MODEL), f32),
        'x_sample': nrm(ks[1], (DEC_BATCH, DEC_SEQ, D_MODEL), f32),
        'cache_k': nrm(ks[2], (DEPTH, DEC_BATCH, wb, N_HEADS_A, HEAD_DIM), f32),
        'cache_v': nrm(ks[3], (DEPTH, DEC_BATCH, wb, N_HEADS_A, HEAD_DIM), f32),
        'norm_g': 1.0 + 0.02 * nrm(ks[4], (DEPTH, D_MODEL), f32),
        'w_in': nrm(ks[5], (DEPTH, D_MODEL, D_IN), f32) * D_MODEL ** -0.5,
        'ln_g': 1.0 + 0.02 * nrm(ks[6], (DEPTH, D_CHUNK), f32),
        'ln_b': 0.02 * nrm(ks[7], (DEPTH, D_CHUNK), f32),
        'w_s': nrm(ks[8], (DEPTH, N_GROUPS_B, CHUNK, CHUNK), f32) * CHUNK ** -0.5,
        'b_s': 1.0 + 0.02 * nrm(ks[9], (DEPTH, N_GROUPS_B, CHUNK), f32),
        'w_out': nrm(ks[10], (DEPTH, D_MIX, D_MODEL), f32) * D_MIX ** -0.5,
        'final_g': 1.0 + 0.02 * nrm(ks[11], (D_MODEL,), f32),
    }


def reference(x_prompt, x_sample, cache_k, cache_v, norm_g, w_in, ln_g, ln_b, w_s, b_s, w_out, final_g):
    S = x_prompt.shape[1]
    T = x_sample.shape[1]
    wb = cache_k.shape[2]
    tail = min(MAX_WINDOW, S)
    pos_p = jnp.arange(S, dtype=jnp.int32)
    pos_s = PAST_LEN + jnp.arange(T, dtype=jnp.int32)
    xp, xs = x_prompt, x_sample
    kp_rows, vp_rows, ks_rows, vs_rows, cs_rows = [], [], [], [], []
    for l in range(DEPTH):
        q, k, v, ga, u, vc, gb = _branch_inputs(xp, pos_p, norm_g[l], w_in[l], ln_g[l], ln_b[l])
        oa = _dilated_attention_prompt(q, k, v)
        oc = _chunk_mlp_prompt(u, vc, w_s[l], b_s[l])
        xp = _output(oa, ga, oc, gb, xp, w_out[l])
        kp_rows.append(k[:, S - tail:])
        vp_rows.append(v[:, S - tail:])
        q, k, v, ga, u, vc, gb = _branch_inputs(xs, pos_s, norm_g[l], w_in[l], ln_g[l], ln_b[l])
        k_all = jnp.concatenate([cache_k[l].astype(k.dtype), k], axis=1)
        v_all = jnp.concatenate([cache_v[l].astype(v.dtype), v], axis=1)
        oa = _dilated_attention_sample(q, k_all, v_all, wb)
        oc = _chunk_mlp_sample(u, vc, w_s[l], b_s[l])
        xs = _output(oa, ga, oc, gb, xs, w_out[l])
        ks_rows.append(k)
        vs_rows.append(v)
        cs_rows.append(vc)
    y_prompt = _rms_norm(xp, final_g)
    y_sample = _rms_norm(xs, final_g)
    return (y_prompt, y_sample, jnp.stack(kp_rows), jnp.stack(vp_rows), jnp.stack(ks_rows), jnp.stack(vs_rows), jnp.stack(cs_rows))
```

```cpp
#include <hip/hip_runtime.h>
#include <cstdio>
#include <cstdint>
#include <cmath>
namespace pg8 {
#define PG8_LAS __attribute__((address_space(3)))
typedef unsigned short bf16_t;
typedef short bf16x8 __attribute__((ext_vector_type(8)));
typedef float f32x4 __attribute__((ext_vector_type(4)));
typedef unsigned u32x4 __attribute__((ext_vector_type(4)));
constexpr int BM = 256, BK = 64, HALF = 128, HTB = HALF * BK * 2  , STAGE_BYTES = 8 * HTB, NXCD = 8, WGM = 8;

__host__ __device__ __forceinline__ int lds_byte(int r, int c) { const int st = (r >> 4) * 2 + (c >> 5), rr = r & 15, cc = c & 31, ob = rr * 64 + cc * 2; return st * 1024 + (ob ^ (((ob >> 9) & 1) << 5)); }
__host__ __device__ __forceinline__ void stage_rc(int b, int& R, int& C) { const int st = b / 1024, sb = b % 1024, swz = sb ^ (((sb >> 9) & 1) << 5); R = (st >> 1) * 16 + swz / 64; C = (st & 1) * 32 + (swz % 64) / 2; }
__host__ __device__ __forceinline__ int perm32(int rho) { const int n = rho >> 4, i = rho & 15; return 8 * (i >> 2) + 4 * n + (i & 3); }

struct Unit { int pm, pn; };
struct Gemm { const bf16_t* A; const bf16_t* Bt; int M, N, K; };

struct StaticOrder {
    int nM, nN, nwg, G, c;
    __host__ __device__ void init(int M, int N, int G_, int c_) { nM = M / BM; nN = N / BM; nwg = nM * nN; G = G_; c = c_; }
    __host__ __device__ bool next(int i, Unit& u) const {
        const long L = (long)i * G + c; if (L >= nwg) return false;
        int wgid = (int)L; { const int q = nwg / NXCD, r = nwg % NXCD, xcd = wgid % NXCD, off = wgid / NXCD; wgid = (xcd < r ? xcd * (q + 1) : r * (q + 1) + (xcd - r) * q) + off; }
        const int nig = WGM * nN, gid = wgid / nig, fm = gid * WGM, gsz = (nM - fm) < WGM ? (nM - fm) : WGM;
        u.pm = fm + ((wgid % nig) % gsz); u.pn = (wgid % nig) / gsz; return true;
    }
    __device__ __forceinline__ void a_ready(const Unit&) const {}
    __device__ __forceinline__ void done(const Unit&) const {}
};
__device__ __forceinline__ unsigned cvt_pk_bf16(float lo, float hi) { unsigned r; asm volatile("v_cvt_pk_bf16_f32 %0, %1, %2" : "=v"(r) : "v"(lo), "v"(hi)); return r; }
template <class Epi, class Sched, bool ALIGN_EPI = false, bool SP2 = false>
__device__ __forceinline__ void gemm_phase(PG8_LAS unsigned char* lds, const Gemm g, const Sched& S, const Epi& E) {
    const int tid = threadIdx.x, wid = __builtin_amdgcn_readfirstlane(tid >> 6), lane = tid & 63, wr = wid >> 2, wc = wid & 3, fr = lane & 15, fq = lane >> 4;
    const int K = g.K, nt = K / BK;
    unsigned voffA[2], voffB[2];
#pragma unroll
    for (int i = 0; i < 2; ++i) { int R, C; stage_rc(tid * 16 + i * 8192, R, C); const int Rb = Epi::PERM ? ((R & ~31) + perm32(R & 31)) : R;
        voffA[i] = (unsigned)(R * K + C) * 2u; voffB[i] = (unsigned)(Rb * K + C) * 2u; }
    const size_t kstep = (size_t)(BK * 2);
    const size_t hstep = (size_t)HALF * K * 2;
    const size_t tstep = 2 * hstep;
    const unsigned ldsw = (unsigned)wid * 1024u;
    const int aoff = lds_byte(wr * 64 + fr, fq * 8), boff = lds_byte(wc * 32 + fr, fq * 8);
#define PG8_SA(b, h) (((b) * 2 + (h)) * HTB)
#define PG8_SB(b, h) ((4 + (b) * 2 + (h)) * HTB)
#define PG8_STAGE(bufoff, gbase, voff) do { _Pragma("unroll") for (int _i = 0; _i < 2; ++_i) \
        __builtin_amdgcn_global_load_lds((const unsigned*)((const char*)(gbase) + (voff)[_i]), (PG8_LAS unsigned*)(lds + (bufoff) + ldsw + _i * 8192), 16, 0, 0); } while (0)
#define PG8_LDA(dst, b, h) do { _Pragma("unroll") for (int m = 0; m < 4; ++m) _Pragma("unroll") for (int k = 0; k < 2; ++k) dst[m][k] = *(const PG8_LAS bf16x8*)(lds + PG8_SA(b, h) + aoff + m * 2048 + k * 1024); } while (0)
#define PG8_LDB(dst, b, h) do { _Pragma("unroll") for (int n = 0; n < 2; ++n) _Pragma("unroll") for (int k = 0; k < 2; ++k) dst[n][k] = *(const PG8_LAS bf16x8*)(lds + PG8_SB(b, h) + boff + n * 2048 + k * 1024); } while (0)
#define PG8_MMA(ai, bj, At, Bt) do { __builtin_amdgcn_s_setprio(1); _Pragma("unroll") for (int m = 0; m < 4; ++m) _Pragma("unroll") for (int n = 0; n < 2; ++n) _Pragma("unroll") for (int k = 0; k < 2; ++k) \
        acc[ai][bj][m][n] = __builtin_amdgcn_mfma_f32_16x16x32_bf16(Bt[n][k], At[m][k], acc[ai][bj][m][n], 0, 0, 0); __builtin_amdgcn_s_setprio(0); } while (0)
#define PG8_WAIT_V(n) asm volatile("s_waitcnt vmcnt(" #n ")" ::: "memory")
#define PG8_WAIT_L(n) asm volatile("s_waitcnt lgkmcnt(" #n ")" ::: "memory")
#define PG8_BAR __builtin_amdgcn_s_barrier()
#define PG8_SCHED __builtin_amdgcn_sched_barrier(0)
    Unit cur, nxt; int ui = 0;
    if (!S.next(0, cur)) return;
    f32x4 acc[2][2][4][2];
#pragma unroll
    for (int a = 0; a < 2; ++a)
#pragma unroll
        for (int b = 0; b < 2; ++b)
#pragma unroll
            for (int m = 0; m < 4; ++m)
#pragma unroll
                for (int n = 0; n < 2; ++n) acc[a][b][m][n] = (f32x4){0.f, 0.f, 0.f, 0.f};
    bf16x8 At[4][2], B0[2][2], B1[2][2];
    const char* cA = (const char*)g.A + (size_t)cur.pm * tstep; const char* cB = (const char*)g.Bt + (size_t)cur.pn * tstep;
    S.a_ready(cur);
    if constexpr (SP2) {
        PG8_STAGE(PG8_SB(0, 0), cB, voffB); PG8_STAGE(PG8_SB(0, 1), cB + hstep, voffB); PG8_STAGE(PG8_SA(0, 0), cA, voffA); PG8_STAGE(PG8_SA(0, 1), cA + hstep, voffA);
        if (wr == 1) PG8_BAR;
        PG8_WAIT_V(2); PG8_BAR;
        PG8_STAGE(PG8_SB(1, 0), cB + kstep, voffB); PG8_STAGE(PG8_SA(1, 0), cA + kstep, voffA); PG8_STAGE(PG8_SB(1, 1), cB + hstep + kstep, voffB);
        PG8_WAIT_V(6); PG8_BAR;
    } else {
        PG8_STAGE(PG8_SB(0, 0), cB, voffB); PG8_STAGE(PG8_SA(0, 0), cA, voffA); PG8_STAGE(PG8_SB(0, 1), cB + hstep, voffB); PG8_STAGE(PG8_SA(0, 1), cA + hstep, voffA);
        if (wr == 1) PG8_BAR;
        PG8_WAIT_V(4); PG8_BAR;
        PG8_STAGE(PG8_SB(1, 0), cB + kstep, voffB); PG8_STAGE(PG8_SA(1, 0), cA + kstep, voffA); PG8_STAGE(PG8_SB(1, 1), cB + hstep + kstep, voffB);
        PG8_WAIT_V(6); PG8_BAR;
    }
    for (;;) {
        const bool has_next = S.next(ui + 1, nxt);
        const char* nA = has_next ? (const char*)g.A + (size_t)nxt.pm * tstep : cA; const char* nB = has_next ? (const char*)g.Bt + (size_t)nxt.pn * tstep : cB;
        for (int t = 0; t < nt; t += 2) {
            const bool last = (t == nt - 2);
            const char* a1 = cA + (size_t)(t + 1) * kstep;
            const char* a2 = last ? nA : cA + (size_t)(t + 2) * kstep; const char* b2 = last ? nB : cB + (size_t)(t + 2) * kstep;
            const char* a3 = a2 + kstep; const char* b3 = b2 + kstep;
            if (last && has_next) S.a_ready(nxt);
            if constexpr (SP2) {
            PG8_LDB(B0, 0, 0); PG8_LDB(B1, 0, 1); PG8_SCHED; PG8_LDA(At, 0, 0); PG8_STAGE(PG8_SA(1, 1), a1 + hstep, voffA);
            PG8_WAIT_V(8); PG8_WAIT_L(0); PG8_BAR; PG8_MMA(0, 0, At, B0); PG8_MMA(0, 1, At, B1); PG8_BAR; PG8_SCHED;
            PG8_LDA(At, 0, 1); PG8_STAGE(PG8_SB(0, 0), b2, voffB); PG8_STAGE(PG8_SB(0, 1), b2 + hstep, voffB); PG8_STAGE(PG8_SA(0, 0), a2, voffA);
            PG8_WAIT_V(8); PG8_WAIT_L(0); PG8_BAR; PG8_MMA(1, 0, At, B0); PG8_MMA(1, 1, At, B1); PG8_BAR; PG8_SCHED;
            PG8_LDB(B0, 1, 0); PG8_LDB(B1, 1, 1); PG8_SCHED; PG8_LDA(At, 1, 0); PG8_STAGE(PG8_SA(0, 1), a2 + hstep, voffA);
            PG8_WAIT_V(8); PG8_WAIT_L(0); PG8_BAR; PG8_MMA(0, 0, At, B0); PG8_MMA(0, 1, At, B1); PG8_BAR; PG8_SCHED;
            PG8_LDA(At, 1, 1); PG8_STAGE(PG8_SB(1, 0), b3, voffB); PG8_STAGE(PG8_SB(1, 1), b3 + hstep, voffB); PG8_STAGE(PG8_SA(1, 0), a3, voffA);
            PG8_WAIT_V(8); PG8_WAIT_L(0); PG8_BAR; PG8_MMA(1, 0, At, B0); PG8_MMA(1, 1, At, B1); PG8_BAR; PG8_SCHED;
            } else {
            PG8_LDB(B0, 0, 0); PG8_SCHED; PG8_LDA(At, 0, 0); PG8_STAGE(PG8_SA(1, 1), a1 + hstep, voffA);
            PG8_WAIT_L(8); PG8_BAR; PG8_WAIT_L(0); PG8_MMA(0, 0, At, B0); PG8_BAR; PG8_SCHED;
            PG8_LDB(B1, 0, 1); PG8_STAGE(PG8_SB(0, 0), b2, voffB);
            PG8_BAR; PG8_WAIT_L(0); PG8_MMA(0, 1, At, B1); PG8_BAR;
            PG8_LDA(At, 0, 1); PG8_STAGE(PG8_SA(0, 0), a2, voffA);
            PG8_BAR; PG8_WAIT_L(0); PG8_MMA(1, 0, At, B0); PG8_BAR; PG8_SCHED;
            PG8_STAGE(PG8_SB(0, 1), b2 + hstep, voffB);
            PG8_WAIT_V(6); PG8_BAR; PG8_MMA(1, 1, At, B1); PG8_BAR;
            PG8_LDB(B0, 1, 0); PG8_SCHED; PG8_LDA(At, 1, 0); PG8_STAGE(PG8_SA(0, 1), a2 + hstep, voffA);
            PG8_WAIT_L(8); PG8_BAR; PG8_WAIT_L(0); PG8_MMA(0, 0, At, B0); PG8_BAR; PG8_SCHED;
            PG8_LDB(B1, 1, 1); PG8_STAGE(PG8_SB(1, 0), b3, voffB);
            PG8_BAR; PG8_WAIT_L(0); PG8_MMA(0, 1, At, B1); PG8_BAR;
            PG8_LDA(At, 1, 1); PG8_STAGE(PG8_SA(1, 0), a3, voffA);
            PG8_BAR; PG8_WAIT_L(0); PG8_MMA(1, 0, At, B0); PG8_BAR; PG8_SCHED;
            PG8_STAGE(PG8_SB(1, 1), b3 + hstep, voffB);
            PG8_WAIT_V(6); PG8_BAR; PG8_MMA(1, 1, At, B1); PG8_BAR;
            }
        }
        if constexpr (ALIGN_EPI) { if (wr == 0) PG8_BAR; }
        if constexpr (!Epi::AFTER_DRAIN) { E(acc, cur, wr, wc, fr, fq); S.done(cur); }
        if (!has_next) break;
#pragma unroll
        for (int a = 0; a < 2; ++a)
#pragma unroll
            for (int b = 0; b < 2; ++b)
#pragma unroll
                for (int m = 0; m < 4; ++m)
#pragma unroll
                    for (int n = 0; n < 2; ++n) acc[a][b][m][n] = (f32x4){0.f, 0.f, 0.f, 0.f};
        cur = nxt; cA = nA; cB = nB; ++ui;
        if constexpr (ALIGN_EPI) { if (wr == 1) PG8_BAR; }
    }
    PG8_WAIT_V(0);
    if constexpr (!ALIGN_EPI) { if (wr == 0) PG8_BAR; }
    PG8_BAR;
    if constexpr (Epi::AFTER_DRAIN) { E.fused(acc, cur, wr, wc, fr, fq, lds, wid, lane); S.done(cur); }
#undef PG8_SA
#undef PG8_SB
#undef PG8_STAGE
#undef PG8_LDA
#undef PG8_LDB
#undef PG8_MMA
#undef PG8_WAIT_V
#undef PG8_WAIT_L
#undef PG8_BAR
#undef PG8_SCHED
}
}

constexpr int NWAVES = 8;
constexpr int DM = 2048, SEQ = 8192, NSAMP = 128, MROWS = SEQ + NSAMP  , MP = 8448  , DIN = 7168, DA = 1024, NHEAD = 16, HDIM = 64;
constexpr int WBUF = 2048, TAIL0 = SEQ - 2048, PAST = 16384, NSLOT = SEQ + 4;
constexpr float EPS = 1e-6f;
constexpr float QSCALE = 0.125f * 1.4426950408889634f;
constexpr size_t OFF_YP = 0, OFF_YS = 16777216, OFF_KT = 17039360, OFF_VT = 19136512, OFF_KS = 21233664, OFF_VS = 21364736, OFF_VC = 21495808, OUT_TOTAL = 21626880;

constexpr size_t MiB = 1u << 20;
constexpr size_t WS_CTL = 0, CTL_ZERO_BYTES = 1 * MiB;
constexpr size_t WS_WIN = 2 * MiB, WS_WOUT = 30 * MiB, WS_XN = 38 * MiB, WS_ROPE = 71 * MiB;
constexpr size_t WS_Q = 74 * MiB, WS_K = 91 * MiB, WS_V = 108 * MiB, WS_GA = 125 * MiB, WS_U = 142 * MiB, WS_GV = 159 * MiB, WS_GB = 176 * MiB;
constexpr size_t WS_STATS = 193 * MiB, WS_AC = 195 * MiB, WS_SS = 228 * MiB, WS_WMP = 230 * MiB, WS_QS = 231 * MiB, WS_END = 232 * MiB;
constexpr int CW_BAR = 4096;

constexpr int LDS_BYTES = 147456;
constexpr int MISC_OFF = LDS_BYTES - 256;
constexpr int ACC_STRIDE = 68;
constexpr int L_ACC = 0, L_ML = 256 * ACC_STRIDE * 4  , L_VB = L_ML + 2048  , L_END_ATT = L_VB + NWAVES * 4096;
static_assert(L_END_ATT <= MISC_OFF, "LDS map");

#define GAS __attribute__((address_space(1)))
#define LAS __attribute__((address_space(3)))
typedef unsigned short bf16;
typedef unsigned v4u __attribute__((ext_vector_type(4)));
typedef float f32x4 __attribute__((ext_vector_type(4)));
typedef short bf16x8 __attribute__((ext_vector_type(8)));
typedef GAS unsigned gu32;
typedef GAS unsigned long long gu64;
#define RLX_AGENT __ATOMIC_RELAXED, __HIP_MEMORY_SCOPE_AGENT
#define LDS_WAIT() asm volatile("s_waitcnt lgkmcnt(0)" ::: "memory")
#define VM_WAIT() asm volatile("s_waitcnt vmcnt(0)" ::: "memory")
__device__ __forceinline__ unsigned long long rt() { return __builtin_amdgcn_s_memrealtime(); }
__device__ __forceinline__ unsigned f2bf(float f) { unsigned u = __builtin_bit_cast(unsigned, f); return (u + 0x7fffu + ((u >> 16) & 1u)) >> 16; }
__device__ __forceinline__ unsigned pk2(float lo, float hi) { return f2bf(lo) | (f2bf(hi) << 16); }
#define XB_TMO      128
#define XB_XCNT(j)  (256  + 64 * (j))
#define XB_XSUB(j)  (1280 + 64 * (j))
#define XB_XGEN(j)  (2304 + 64 * (j))
#define XB_TOP      3328
#define XB_TOPGEN   3392
#define XCD_BAR_WORDS 3456
#define XB_SPIN_CAP (1u << 18)

__device__ __forceinline__ unsigned xb_ld(unsigned* p)              { return __hip_atomic_load(p, __ATOMIC_RELAXED, __HIP_MEMORY_SCOPE_AGENT); }
__device__ __forceinline__ unsigned xb_add(unsigned* p, unsigned v) { return __hip_atomic_fetch_add(p, v, __ATOMIC_RELAXED, __HIP_MEMORY_SCOPE_AGENT); }
__device__ __forceinline__ unsigned xb_xcc_id() { return (unsigned)__builtin_amdgcn_s_getreg((3 << 11) | 20) & 0xFu; }
#define XB_SPIN(cond, bar) do { unsigned _sp = 0; while (cond) { __builtin_amdgcn_s_sleep(1); \
    if ((++_sp & 255u) == 0u) { if (xb_ld(&(bar)[XB_TMO])) break; if (_sp > XB_SPIN_CAP) { atomicAdd(&(bar)[XB_TMO], 1u); break; } } } } while (0)

struct XcdBarrier {
    unsigned* bar; unsigned x;
    volatile LAS unsigned* st;
};

__device__ __forceinline__ XcdBarrier xcd_barrier_post(unsigned* bar, volatile LAS unsigned* st) {
    XcdBarrier b; b.bar = bar; b.x = xb_xcc_id(); b.st = st;
    if (threadIdx.x == 0) (void)xb_add(&bar[XB_XCNT(b.x)], 1u);
    return b;
}
__device__ __forceinline__ void xcd_barrier_complete(unsigned* bar, unsigned x, unsigned& nloc, unsigned& nx) {
    const unsigned G = gridDim.x * gridDim.y * gridDim.z;
    unsigned sum, cnt, mine, sp = 0u;
    for (;;) {
        sum = 0u; cnt = 0u; mine = 0u;
#pragma unroll
        for (unsigned j = 0; j < 16; ++j) { const unsigned c = xb_ld(&bar[XB_XCNT(j)]); sum += c; cnt += (c > 0u) ? 1u : 0u; mine = (j == x) ? c : mine; }
        if (sum == G) break;
        __builtin_amdgcn_s_sleep(1);
        if ((++sp & 255u) == 0u) { if (xb_ld(&bar[XB_TMO])) break; if (sp > XB_SPIN_CAP) { atomicAdd(&bar[XB_TMO], 1u); break; } }
    }
    nloc = mine > 0u ? mine : 1u; nx = cnt > 0u ? cnt : 1u;
}

__device__ __forceinline__ void xcd_barrier(const XcdBarrier& b) {
    asm volatile("s_waitcnt vmcnt(0)" ::: "memory");
    __syncthreads();
    if (threadIdx.x == 0) {
        unsigned* bar = b.bar;
        __builtin_amdgcn_s_waitcnt(0);
        unsigned nloc = b.st[0], nx = b.st[1];
        if (nloc == 0u) { xcd_barrier_complete(bar, b.x, nloc, nx); b.st[0] = nloc; b.st[1] = nx; }
        const unsigned old = xb_add(&bar[XB_XSUB(b.x)], 1u);
        const unsigned gen = old / nloc;
        if (old + 1u == (gen + 1u) * nloc) {
            __builtin_amdgcn_fence(__ATOMIC_RELEASE, "agent");
            asm volatile("s_waitcnt vmcnt(0)" ::: "memory");
            const unsigned og = xb_add(&bar[XB_TOP], 1u);
            const unsigned tg = og / nx;
            if (og + 1u == (tg + 1u) * nx) xb_add(&bar[XB_TOPGEN], 1u);
            else XB_SPIN(xb_ld(&bar[XB_TOPGEN]) == tg, bar);
            __builtin_amdgcn_fence(__ATOMIC_ACQUIRE, "agent");
            xb_add(&bar[XB_XGEN(b.x)], 1u);
            asm volatile("s_waitcnt vmcnt(0)" ::: "memory");
        } else {
            XB_SPIN(xb_ld(&bar[XB_XGEN(b.x)]) == gen, bar);
            __builtin_amdgcn_fence(__ATOMIC_ACQUIRE, "agent");
            asm volatile("s_waitcnt vmcnt(0)" ::: "memory");
        }
    }
    __syncthreads();
}

struct Frame {
    LAS unsigned char* lds;
    int tid, lane, wave, vcu, G;
};
struct Args { const float* in[12]; float* out; unsigned char* ws; double invf[32]; };

typedef float f32x2v __attribute__((ext_vector_type(2)));
typedef unsigned u32x2v __attribute__((ext_vector_type(2)));
typedef short s16x4 __attribute__((ext_vector_type(4)));

__device__ __forceinline__ float wave_sum(float v) {
#pragma unroll
    for (int o = 1; o < 64; o <<= 1) v += __shfl_xor(v, o);
    return v;
}
__device__ __forceinline__ unsigned cvtpk(float lo, float hi) { return pg8::cvt_pk_bf16(lo, hi); }
__device__ __forceinline__ float bf2f(unsigned short b) { return __builtin_bit_cast(float, (unsigned)b << 16); }
__device__ __forceinline__ float bflo(unsigned w) { return __builtin_bit_cast(float, w << 16); }
__device__ __forceinline__ float bfhi(unsigned w) { return __builtin_bit_cast(float, w & 0xffff0000u); }
__device__ __forceinline__ float xsig(float x, float z) { return x * __builtin_amdgcn_rcpf(1.0f + __builtin_amdgcn_exp2f(-1.4426950408889634f * z)); }
__device__ __forceinline__ float silu_f(float x) { return xsig(x, x); }
__device__ __forceinline__ float gelu_f(float x) { return xsig(x, 1.5957691216057308f * (x + 0.044715f * x * x * x)); }

__device__ __forceinline__ int dest_row_in(int n) { if (n >= 2 * DA) return n; const int l = n & 63, hb = n & ~63; return hb + (l < 32 ? 2 * l : 2 * (l - 32) + 1); }
__device__ __forceinline__ void p0_transpose_item(const float* W, int K, int N, bf16* WT, const float* gk, bool perm, LAS float* scr, int item, int lane) {
    const int nblk = N / 32, kb = item / nblk, nb = item % nblk, k0 = 64 * kb, n0 = 32 * nb;
#pragma unroll 8
    for (int i = 0; i < 32; ++i) { const int kk = 2 * i + (lane >> 5); float w = W[(size_t)(k0 + kk) * N + n0 + (lane & 31)]; if (gk) w *= gk[k0 + kk]; scr[kk * 33 + (lane & 31)] = w; }
    LDS_WAIT(); asm volatile("" ::: "memory");
    const int c = lane & 7;
#pragma unroll
    for (int j = 0; j < 4; ++j) { const int n = (lane >> 3) + 8 * j; const LAS float* s = scr + (8 * c) * 33 + n;
        v4u o; o.x = pk2(s[0 * 33], s[1 * 33]); o.y = pk2(s[2 * 33], s[3 * 33]); o.z = pk2(s[4 * 33], s[5 * 33]); o.w = pk2(s[6 * 33], s[7 * 33]);
        const int dr = perm ? dest_row_in(n0 + n) : (n0 + n);
        *(GAS v4u*)(WT + (size_t)dr * K + k0 + 8 * c) = o; }
    LDS_WAIT(); asm volatile("" ::: "memory");
}
__device__ __forceinline__ void rms_row_to_bf16(int lane, const float* xrow, bf16* orow) {
    GAS unsigned long long* o8 = (GAS unsigned long long*)orow + lane;
    if (xrow == nullptr) {
#pragma unroll
        for (int j = 0; j < 8; ++j) o8[64 * j] = 0ull;
        return;
    }
    const GAS f32x4* xr = (const GAS f32x4*)xrow + lane;
    f32x4 v[8]; float s = 0.f;
#pragma unroll
    for (int j = 0; j < 8; ++j) { v[j] = xr[64 * j]; s += (v[j].x * v[j].x + v[j].y * v[j].y) + (v[j].z * v[j].z + v[j].w * v[j].w); }
    const float r = 1.0f / sqrtf(wave_sum(s) * (1.0f / DM) + EPS);
#pragma unroll
    for (int j = 0; j < 8; ++j) o8[64 * j] = (unsigned long long)pk2(v[j].x * r, v[j].y * r) | ((unsigned long long)pk2(v[j].z * r, v[j].w * r) << 32);
}
__device__ __forceinline__ void p0_prologue(const Frame& F, const Args& A) {
    unsigned char* ws = A.ws;
    LAS float* scr = (LAS float*)(F.lds + F.wave * 16384);
    const int gw = F.vcu * NWAVES + F.wave, NGW = F.G * NWAVES;
    constexpr int I_IN = (DM / 64) * (DIN / 32), I_OUT = (DM / 64) * (DM / 32);
    for (int it = gw; it < I_IN + I_OUT; it += NGW) {
        if (it < I_IN) p0_transpose_item(A.in[5], DM, DIN, (bf16*)(ws + WS_WIN), A.in[4], true, scr, it, F.lane);
        else p0_transpose_item(A.in[10], DM, DM, (bf16*)(ws + WS_WOUT), nullptr, false, scr, it - I_IN, F.lane);
    }
    for (int m = gw; m < MP; m += NGW) {
        const float* xrow = m < SEQ ? A.in[0] + (size_t)m * DM : (m < MROWS ? A.in[1] + (size_t)(m - SEQ) * DM : nullptr);
        rms_row_to_bf16(F.lane, xrow, (bf16*)(ws + WS_XN) + (size_t)m * DM);
    }
    const int gt = gw * 64 + F.lane, NGT = NGW * 64;
    float* rope = (float*)(ws + WS_ROPE);
    for (int e = gt; e < NSLOT * 32; e += NGT) {
        const int slot = e >> 5, i = e & 31;
        const int pos = slot < SEQ ? slot : PAST + (slot - SEQ);
        const double ang = (double)pos * A.invf[i];
        const double kq = rint(ang * 0.15915494309189535);
        double r = fma(-kq, 6.283185307179586, ang); r = fma(-kq, 2.4492935982947064e-16, r);
        const float rf = (float)r;
        f32x2v cs; cs.x = cosf(rf); cs.y = sinf(rf);
        *(f32x2v*)(rope + 2 * (size_t)e) = cs;
    }
    bf16* wmp = (bf16*)(ws + WS_WMP);
    for (int e = gt; e < 8 * 128 * 128; e += NGT) {
        const int kp = e & 127, t = (e >> 7) & 127, g = e >> 14;
        const int ss = kp >> 5, q = (kp >> 3) & 3, j = kp & 7, s = 32 * ss + 16 * (j >> 2) + 4 * q + (j & 3);
        const float w = s <= t ? A.in[8][(size_t)(g * 128 + t) * 128 + s] : 0.f;
        wmp[e] = (bf16)f2bf(w);
    }
}

struct EpiIn {
    static constexpr bool PERM = true, AFTER_DRAIN = false;
    bf16 *Q, *K, *V, *GA, *U, *GV, *GB;
    const float* rope; float* stats; float* out; float* qs;
    __device__ __forceinline__ void operator()(const pg8::f32x4 (&acc)[2][2][4][2], const pg8::Unit& u, int wr, int wc, int fr, int fq) const {
        const int sec = u.pn >> 2;
        const int col0 = (u.pn & 3) * 256 + wc * 32 + 8 * fq;
        const int row0 = u.pm * 256 + wr * 64 + fr;
        if (sec <= 1) {
            bf16* dstb = sec == 0 ? Q : K;
            const float sc = sec == 0 ? QSCALE : 1.0f;
#pragma unroll
            for (int ai = 0; ai < 2; ++ai)
#pragma unroll
                for (int m = 0; m < 4; ++m) {
                    const int row = row0 + ai * 128 + m * 16;
                    const int slot = row < SEQ ? row : SEQ + ((row - SEQ) & 3);
                    float* fdst = nullptr;
                    if (sec == 1) { if (row >= TAIL0 && row < SEQ) fdst = out + OFF_KT + (size_t)(row - TAIL0) * DA; else if (row >= SEQ && row < MROWS) fdst = out + OFF_KS + (size_t)(row - SEQ) * DA; }
                    else { if (row >= SEQ && row < MROWS) fdst = qs + (size_t)(row - SEQ) * DA; }
#pragma unroll
                    for (int bj = 0; bj < 2; ++bj) {
                        const int cl = col0 + bj * 128, hb = cl & ~63, i0 = (cl & 63) >> 1;
                        const float* tp = rope + ((size_t)slot * 32 + i0) * 2;
                        const f32x4 t0 = *(const f32x4*)tp, t1 = *(const f32x4*)(tp + 4);
                        const f32x4 v0 = acc[ai][bj][m][0], v1 = acc[ai][bj][m][1];
                        f32x4 y1, y2;
                        y1[0] = (v0[0] * t0[0] - v0[1] * t0[1]) * sc; y2[0] = (v0[1] * t0[0] + v0[0] * t0[1]) * sc;
                        y1[1] = (v0[2] * t0[2] - v0[3] * t0[3]) * sc; y2[1] = (v0[3] * t0[2] + v0[2] * t0[3]) * sc;
                        y1[2] = (v1[0] * t1[0] - v1[1] * t1[1]) * sc; y2[2] = (v1[1] * t1[0] + v1[0] * t1[1]) * sc;
                        y1[3] = (v1[2] * t1[2] - v1[3] * t1[3]) * sc; y2[3] = (v1[3] * t1[2] + v1[2] * t1[3]) * sc;
                        v4u w; w.x = cvtpk(y1[0], y2[0]); w.y = cvtpk(y1[1], y2[1]); w.z = cvtpk(y1[2], y2[2]); w.w = cvtpk(y1[3], y2[3]);
                        *(v4u*)(dstb + (size_t)row * DA + cl) = w;
                        if (fdst) { *(f32x4*)(fdst + hb + i0) = y1; *(f32x4*)(fdst + hb + 32 + i0) = y2; }
                    }
                }
        } else if (sec == 2) {
#pragma unroll
            for (int ai = 0; ai < 2; ++ai)
#pragma unroll
                for (int m = 0; m < 4; ++m) {
                    const int row = row0 + ai * 128 + m * 16;
                    float* fdst = nullptr;
                    if (row >= TAIL0 && row < SEQ) fdst = out + OFF_VT + (size_t)(row - TAIL0) * DA; else if (row >= SEQ && row < MROWS) fdst = out + OFF_VS + (size_t)(row - SEQ) * DA;
#pragma unroll
                    for (int bj = 0; bj < 2; ++bj) {
                        const int cl = col0 + bj * 128;
                        const f32x4 v0 = acc[ai][bj][m][0], v1 = acc[ai][bj][m][1];
                        v4u w; w.x = cvtpk(v0[0], v0[1]); w.y = cvtpk(v0[2], v0[3]); w.z = cvtpk(v1[0], v1[1]); w.w = cvtpk(v1[2], v1[3]);
                        *(v4u*)(V + (size_t)row * DA + cl) = w;
                        if (fdst) { *(f32x4*)(fdst + cl) = v0; *(f32x4*)(fdst + cl + 4) = v1; }
                    }
                }
        } else if (sec == 3 || sec == 6) {
            bf16* dstb = sec == 3 ? GA : GB;
#pragma unroll
            for (int ai = 0; ai < 2; ++ai)
#pragma unroll
                for (int m = 0; m < 4; ++m) {
                    const int row = row0 + ai * 128 + m * 16;
#pragma unroll
                    for (int bj = 0; bj < 2; ++bj) {
                        const int cl = col0 + bj * 128;
                        const f32x4 v0 = acc[ai][bj][m][0], v1 = acc[ai][bj][m][1];
                        v4u w; w.x = cvtpk(silu_f(v0[0]), silu_f(v0[1])); w.y = cvtpk(silu_f(v0[2]), silu_f(v0[3])); w.z = cvtpk(silu_f(v1[0]), silu_f(v1[1])); w.w = cvtpk(silu_f(v1[2]), silu_f(v1[3]));
                        *(v4u*)(dstb + (size_t)row * DA + cl) = w;
                    }
                }
        } else {
            bf16* dstb = sec == 4 ? U : GV;
#pragma unroll
            for (int ai = 0; ai < 2; ++ai)
#pragma unroll
                for (int m = 0; m < 4; ++m) {
                    const int row = row0 + ai * 128 + m * 16;
                    float s1 = 0.f, s2 = 0.f;
#pragma unroll
                    for (int bj = 0; bj < 2; ++bj) {
                        const int cl = col0 + bj * 128;
                        f32x4 v0 = acc[ai][bj][m][0], v1 = acc[ai][bj][m][1];
#pragma unroll
                        for (int e = 0; e < 4; ++e) { v0[e] = gelu_f(v0[e]); v1[e] = gelu_f(v1[e]); s1 += v0[e] + v1[e]; s2 += v0[e] * v0[e] + v1[e] * v1[e]; }
                        v4u w; w.x = cvtpk(v0[0], v0[1]); w.y = cvtpk(v0[2], v0[3]); w.z = cvtpk(v1[0], v1[1]); w.w = cvtpk(v1[2], v1[3]);
                        *(v4u*)(dstb + (size_t)row * DA + cl) = w;
                    }
                    if (sec == 5) {
                        s1 += __shfl_xor(s1, 16); s1 += __shfl_xor(s1, 32); s2 += __shfl_xor(s2, 16); s2 += __shfl_xor(s2, 32);
                        if (fq == 0) { f32x2v p; p.x = s1; p.y = s2; *(f32x2v*)(stats + ((size_t)row * 16 + (u.pn & 3) * 4 + wc) * 2) = p; }
                    }
                }
        }
    }
};

struct EpiOut {
    static constexpr bool PERM = false, AFTER_DRAIN = false;
    const float* xp; const float* xs; float* out; float* ssq;
    __device__ __forceinline__ void operator()(const pg8::f32x4 (&acc)[2][2][4][2], const pg8::Unit& u, int wr, int wc, int fr, int fq) const {
        const int row0 = u.pm * 256 + wr * 64 + fr, col0 = u.pn * 256 + wc * 32 + 4 * fq;
#pragma unroll
        for (int ai = 0; ai < 2; ++ai) {
            if (u.pm * 256 + ai * 128 >= MROWS) continue;
#pragma unroll
            for (int m = 0; m < 4; ++m) {
                const int row = row0 + ai * 128 + m * 16;
                const float* xr = row < SEQ ? xp + (size_t)row * DM : xs + (size_t)(row - SEQ) * DM;
                float* orow = out + (size_t)row * DM;
                float ss = 0.f;
#pragma unroll
                for (int bj = 0; bj < 2; ++bj)
#pragma unroll
                    for (int n = 0; n < 2; ++n) {
                        const int col = col0 + bj * 128 + n * 16;
                        const f32x4 r = *(const f32x4*)(xr + col) + acc[ai][bj][m][n];
                        *(f32x4*)(orow + col) = r;
                        ss += (r[0] * r[0] + r[1] * r[1]) + (r[2] * r[2] + r[3] * r[3]);
                    }
                ss += __shfl_xor(ss, 16); ss += __shfl_xor(ss, 32);
                if (fq == 0) ssq[(size_t)row * 32 + u.pn * 4 + wc] = ss;
            }
        }
    }
};

typedef short v4i16_t __attribute__((ext_vector_type(4)));
__device__ __forceinline__ s16x4 ldtr(LAS const unsigned char* p) { return __builtin_bit_cast(s16x4, __builtin_amdgcn_ds_read_tr16_b64_v4i16((LAS v4i16_t*)p)); }
#define MFMA16(a, b, c) __builtin_amdgcn_mfma_f32_16x16x32_bf16((a), (b), (c), 0, 0, 0)

struct P2Ptrs { const bf16 *Q, *K, *V, *GA, *U, *GV, *GB, *WMP; const float* stats; bf16* AC; const float *ck, *cv, *ksn, *vsn, *qs, *ln_g, *ln_b, *w_s, *b_s; float* vc_out; };

__device__ __forceinline__ void attn_item(const Frame& F, const P2Ptrs& T, int h, int P0) {
    const int lane = F.lane, w = F.wave, q16 = lane & 15, g = lane >> 4;
    LAS float* ACC = (LAS float*)(F.lds + L_ACC);
    LAS float* ML = (LAS float*)(F.lds + L_ML);
    LAS unsigned char* VB = F.lds + L_VB + w * 4096;
    const bf16* Qh = T.Q + h * HDIM; const bf16* Kh = T.K + h * HDIM; const bf16* Vh = T.V + h * HDIM;
    const int vc_ = lane & 7, vk_ = lane >> 3;
    const int vwoff = (vc_ >> 1) * 1024 + vk_ * 32 + (vc_ & 1) * 16;
    const int troff = (4 * g + (q16 >> 2)) * 32 + (q16 & 3) * 8;
#pragma unroll 1
    for (int p = 0; p < 3; ++p) {
        const int d = p == 0 ? 1 : (p == 1 ? 4 : 16);
#pragma unroll 1
        for (int tt = 0; tt < 2; ++tt) {
            const int tau = 2 * w + tt;
            const int qrel0 = p == 0 ? 16 * tau : (p == 1 ? (tau & 3) + 64 * (tau >> 2) : tau);
            const int pb = P0 + qrel0;
            const bf16* qp = Qh + (size_t)(pb + d * q16) * DA + 8 * g;
            const bf16x8 qf0 = *(const bf16x8*)qp, qf1 = *(const bf16x8*)(qp + 32);
            v4u vreg[4];
#pragma unroll
            for (int i = 0; i < 4; ++i) { int pk = pb + d * (8 * i + vk_ - 144); pk = pk < 0 ? 0 : pk; vreg[i] = *(const v4u*)(Vh + (size_t)pk * DA + 8 * vc_); }
            f32x4 st[10];
            st[0] = (f32x4){0.f, 0.f, 0.f, 0.f};
#pragma unroll
            for (int kt = 1; kt < 10; ++kt) {
                int pk = pb + d * (16 * kt + q16 - 144); pk = pk < 0 ? 0 : pk;
                const bf16* kp = Kh + (size_t)pk * DA + 8 * g;
                const bf16x8 kf0 = *(const bf16x8*)kp, kf1 = *(const bf16x8*)(kp + 32);
                f32x4 a = MFMA16(kf0, qf0, ((f32x4){0.f, 0.f, 0.f, 0.f}));
                st[kt] = MFMA16(kf1, qf1, a);
            }
            const float NEG = -INFINITY;
#pragma unroll
            for (int r = 0; r < 4; ++r) { const int rk = 4 * g + r; if (rk < q16) st[1][r] = NEG; if (rk > q16) st[9][r] = NEG; }
            if (pb < 128 * d) {
#pragma unroll
                for (int kt = 1; kt < 10; ++kt)
#pragma unroll
                    for (int r = 0; r < 4; ++r) if (pb + d * (16 * kt + 4 * g + r - 144) < 0) st[kt][r] = NEG;
            }
            float mx = NEG;
#pragma unroll
            for (int kt = 1; kt < 10; ++kt) mx = fmaxf(fmaxf(fmaxf(st[kt][0], st[kt][1]), fmaxf(st[kt][2], st[kt][3])), mx);
            mx = fmaxf(mx, __shfl_xor(mx, 16)); mx = fmaxf(mx, __shfl_xor(mx, 32));
            float ls = 0.f;
#pragma unroll
            for (int kt = 1; kt < 10; ++kt)
#pragma unroll
                for (int r = 0; r < 4; ++r) { const float e = __builtin_amdgcn_exp2f(st[kt][r] - mx); st[kt][r] = e; ls += e; }
            ls += __shfl_xor(ls, 16); ls += __shfl_xor(ls, 32);
            f32x4 o[4];
#pragma unroll
            for (int n = 0; n < 4; ++n) o[n] = (f32x4){0.f, 0.f, 0.f, 0.f};
#pragma unroll
            for (int s = 0; s < 5; ++s) {
#pragma unroll
                for (int i = 0; i < 4; ++i) *(LAS v4u*)(VB + vwoff + i * 256) = vreg[i];
                if (s < 4) {
#pragma unroll
                    for (int i = 0; i < 4; ++i) { int pk = pb + d * (32 * (s + 1) + 8 * i + vk_ - 144); pk = pk < 0 ? 0 : pk; vreg[i] = *(const v4u*)(Vh + (size_t)pk * DA + 8 * vc_); }
                }
                v4u pw; pw.x = cvtpk(st[2 * s][0], st[2 * s][1]); pw.y = cvtpk(st[2 * s][2], st[2 * s][3]); pw.z = cvtpk(st[2 * s + 1][0], st[2 * s + 1][1]); pw.w = cvtpk(st[2 * s + 1][2], st[2 * s + 1][3]);
                const bf16x8 pf = __builtin_bit_cast(bf16x8, pw);
#pragma unroll
                for (int n = 0; n < 4; ++n) {
                    const s16x4 lo = ldtr(VB + troff + n * 1024), hi = ldtr(VB + troff + n * 1024 + 512);
                    const bf16x8 vf = (bf16x8){lo[0], lo[1], lo[2], lo[3], hi[0], hi[1], hi[2], hi[3]};
                    o[n] = MFMA16(pf, vf, o[n]);
                }
            }
#pragma unroll
            for (int r = 0; r < 4; ++r) {
                const int rho = 4 * g + r;
                const float mp = __shfl(mx, rho), lp = __shfl(ls, rho);
                const int qrel = qrel0 + d * rho;
                LAS float* arow = ACC + qrel * ACC_STRIDE + q16;
                if (p == 0) {
#pragma unroll
                    for (int n = 0; n < 4; ++n) arow[16 * n] = o[n][r];
                    if (q16 == 0) { ML[2 * qrel] = mp; ML[2 * qrel + 1] = lp; }
                } else {
                    const float mo = ML[2 * qrel], lo_ = ML[2 * qrel + 1];
                    const float mn = fmaxf(mo, mp), ao = __builtin_amdgcn_exp2f(mo - mn), ap = __builtin_amdgcn_exp2f(mp - mn), ln = lo_ * ao + lp * ap;
                    if (p == 1) {
#pragma unroll
                        for (int n = 0; n < 4; ++n) arow[16 * n] = arow[16 * n] * ao + o[n][r] * ap;
                        if (q16 == 0) { ML[2 * qrel] = mn; ML[2 * qrel + 1] = ln; }
                    } else {
                        const float inv = 1.0f / ln;
#pragma unroll
                        for (int n = 0; n < 4; ++n) arow[16 * n] = (arow[16 * n] * ao + o[n][r] * ap) * inv;
                    }
                }
            }
        }
        __syncthreads();
    }
#pragma unroll
    for (int i = 0; i < 4; ++i) {
        const int idx = F.tid + 512 * i, qrel = idx >> 3, c8 = idx & 7;
        const LAS float* ar = ACC + qrel * ACC_STRIDE + 8 * c8;
        const f32x4 a0 = *(const LAS f32x4*)ar, a1 = *(const LAS f32x4*)(ar + 4);
        const v4u gw = *(const v4u*)(T.GA + (size_t)(P0 + qrel) * DA + h * HDIM + 8 * c8);
        v4u o; o.x = cvtpk(a0[0] * bflo(gw.x), a0[1] * bfhi(gw.x)); o.y = cvtpk(a0[2] * bflo(gw.y), a0[3] * bfhi(gw.y));
        o.z = cvtpk(a1[0] * bflo(gw.z), a1[1] * bfhi(gw.z)); o.w = cvtpk(a1[2] * bflo(gw.w), a1[3] * bfhi(gw.w));
        *(v4u*)(T.AC + (size_t)(P0 + qrel) * DM + h * HDIM + 8 * c8) = o;
    }
    __syncthreads();
}

__device__ __forceinline__ void gmlp_item(const Frame& F, const P2Ptrs& T, int ck, int gi) {
    const int lane = F.lane, w = F.wave, q16 = lane & 15, g = lane >> 4, tid = F.tid;
    LAS unsigned char* IMG = F.lds;
    LAS f32x2v* RS = (LAS f32x2v*)(F.lds + 32768);
    const int r0 = ck * 128, ch0 = gi * 128;
    if (tid < 128) {
        const float* sp = T.stats + (size_t)(r0 + tid) * 32; float s1 = 0.f, s2 = 0.f;
#pragma unroll
        for (int i = 0; i < 8; ++i) { const f32x4 v = *(const f32x4*)(sp + 4 * i); s1 += v[0] + v[2]; s2 += v[1] + v[3]; }
        const float mu = s1 * (1.0f / DA), var = fmaxf(s2 * (1.0f / DA) - mu * mu, 0.f);
        f32x2v o; o.x = mu; o.y = 1.0f / sqrtf(var + EPS); RS[tid] = o;
    }
    __syncthreads();
#pragma unroll
    for (int i = 0; i < 4; ++i) {
        const int idx = tid + 512 * i, s = idx >> 4, c8 = idx & 15;
        const v4u gv = *(const v4u*)(T.GV + (size_t)(r0 + s) * DA + ch0 + 8 * c8);
        const f32x4 lg0 = *(const f32x4*)(T.ln_g + ch0 + 8 * c8), lg1 = *(const f32x4*)(T.ln_g + ch0 + 8 * c8 + 4);
        const f32x4 lb0 = *(const f32x4*)(T.ln_b + ch0 + 8 * c8), lb1 = *(const f32x4*)(T.ln_b + ch0 + 8 * c8 + 4);
        const f32x2v ms = RS[s];
        v4u o;
        o.x = cvtpk((bflo(gv.x) - ms.x) * ms.y * lg0[0] + lb0[0], (bfhi(gv.x) - ms.x) * ms.y * lg0[1] + lb0[1]);
        o.y = cvtpk((bflo(gv.y) - ms.x) * ms.y * lg0[2] + lb0[2], (bfhi(gv.y) - ms.x) * ms.y * lg0[3] + lb0[3]);
        o.z = cvtpk((bflo(gv.z) - ms.x) * ms.y * lg1[0] + lb1[0], (bfhi(gv.z) - ms.x) * ms.y * lg1[1] + lb1[1]);
        o.w = cvtpk((bflo(gv.w) - ms.x) * ms.y * lg1[2] + lb1[2], (bfhi(gv.w) - ms.x) * ms.y * lg1[3] + lb1[3]);
        *(LAS v4u*)(IMG + (c8 >> 1) * 4096 + s * 32 + (c8 & 1) * 16) = o;
    }
    __syncthreads();
    bf16x8 bfr[4];
    const int troff = w * 4096 + (4 * g + (q16 >> 2)) * 32 + (q16 & 3) * 8;
#pragma unroll
    for (int ss = 0; ss < 4; ++ss) {
        const s16x4 lo = ldtr(IMG + troff + ss * 1024), hi = ldtr(IMG + troff + ss * 1024 + 512);
        bfr[ss] = (bf16x8){lo[0], lo[1], lo[2], lo[3], hi[0], hi[1], hi[2], hi[3]};
    }
    const bf16* wm = T.WMP + (size_t)gi * 128 * 128;
    const int ch = ch0 + 16 * w + q16;
#pragma unroll
    for (int tt = 0; tt < 8; ++tt) {
        f32x4 acc = (f32x4){0.f, 0.f, 0.f, 0.f};
#pragma unroll
        for (int ss = 0; ss < 4; ++ss) {
            if (ss <= (tt >> 1)) {
                const bf16x8 af = *(const bf16x8*)(wm + (size_t)(16 * tt + q16) * 128 + 32 * ss + 8 * g);
                acc = MFMA16(af, bfr[ss], acc);
            }
        }
#pragma unroll
        for (int r = 0; r < 4; ++r) {
            const int t = 16 * tt + 4 * g + r; const size_t row = (size_t)(r0 + t);
            const float mixed = acc[r] + T.b_s[gi * 128 + t];
            const float uu = bf2f(T.U[row * DA + ch]), gb = bf2f(T.GB[row * DA + ch]);
            T.AC[row * DM + DA + ch] = (bf16)f2bf(uu * mixed * gb);
        }
    }
    __syncthreads();
}

__device__ __forceinline__ void sattn_item(const Frame& F, const P2Ptrs& T, int si) {
    const int lane = F.lane, w = F.wave, kk = lane >> 2, part = lane & 3;
    const int b = si >> 6, h = (si >> 2) & 15, t = si & 3;
    LAS float* SC = (LAS float*)(F.lds + w * 2048);
    const float* qp = T.qs + (size_t)(b * 4 + t) * DA + h * HDIM + 4 * part;
    f32x4 qv[4];
#pragma unroll
    for (int i = 0; i < 4; ++i) qv[i] = *(const f32x4*)(qp + 16 * i);
    float mx = -INFINITY;
#pragma unroll 1
    for (int p = 0; p < 3; ++p) {
        const int d = p == 0 ? 1 : (p == 1 ? 4 : 16);
#pragma unroll 3
        for (int ps = 0; ps < 9; ++ps) {
            const int j = ps * 16 + kk, jj = j > 128 ? 128 : j, idx = WBUF + t - jj * d;
            const float* kr = idx >= WBUF ? T.ksn + ((size_t)(b * 4 + idx - WBUF) * NHEAD + h) * HDIM : T.ck + ((size_t)(b * WBUF + idx) * NHEAD + h) * HDIM;
            kr += 4 * part;
            float s = 0.f;
#pragma unroll
            for (int i = 0; i < 4; ++i) { const f32x4 kv = *(const f32x4*)(kr + 16 * i); s += (qv[i][0] * kv[0] + qv[i][1] * kv[1]) + (qv[i][2] * kv[2] + qv[i][3] * kv[3]); }
            s += __shfl_xor(s, 1); s += __shfl_xor(s, 2);
            if (j > 128) s = -INFINITY;
            if (part == 0) SC[p * 144 + ps * 16 + kk] = s;
            mx = fmaxf(mx, s);
        }
    }
    mx = fmaxf(mx, __shfl_xor(mx, 4)); mx = fmaxf(mx, __shfl_xor(mx, 8)); mx = fmaxf(mx, __shfl_xor(mx, 16)); mx = fmaxf(mx, __shfl_xor(mx, 32));
    f32x4 o[4]; float ls = 0.f;
#pragma unroll
    for (int i = 0; i < 4; ++i) o[i] = (f32x4){0.f, 0.f, 0.f, 0.f};
#pragma unroll 1
    for (int p = 0; p < 3; ++p) {
        const int d = p == 0 ? 1 : (p == 1 ? 4 : 16);
#pragma unroll 3
        for (int ps = 0; ps < 9; ++ps) {
            const int j = ps * 16 + kk, jj = j > 128 ? 128 : j, idx = WBUF + t - jj * d;
            const float* vr = idx >= WBUF ? T.vsn + ((size_t)(b * 4 + idx - WBUF) * NHEAD + h) * HDIM : T.cv + ((size_t)(b * WBUF + idx) * NHEAD + h) * HDIM;
            vr += 4 * part;
            const float pe = __builtin_amdgcn_exp2f(SC[p * 144 + ps * 16 + kk] - mx);
            ls += pe;
#pragma unroll
            for (int i = 0; i < 4; ++i) { const f32x4 vv = *(const f32x4*)(vr + 16 * i); o[i] += vv * pe; }
        }
    }
#pragma unroll
    for (int sh = 4; sh < 64; sh <<= 1) {
        ls += __shfl_xor(ls, sh);
#pragma unroll
        for (int i = 0; i < 4; ++i)
#pragma unroll
            for (int e = 0; e < 4; ++e) o[i][e] += __shfl_xor(o[i][e], sh);
    }
    if (kk == 0) {
        const float inv = 1.0f / ls;
        const size_t row = (size_t)(SEQ + b * 4 + t);
#pragma unroll
        for (int i = 0; i < 4; ++i) {
            const int c = h * HDIM + 16 * i + 4 * part;
            const u32x2v gw = *(const u32x2v*)(T.GA + row * DA + c);
            u32x2v ov; ov.x = cvtpk(o[i][0] * inv * bflo(gw.x), o[i][1] * inv * bfhi(gw.x)); ov.y = cvtpk(o[i][2] * inv * bflo(gw.y), o[i][3] * inv * bfhi(gw.y));
            *(u32x2v*)(T.AC + row * DM + c) = ov;
        }
    }
}

__device__ __forceinline__ void sgmlp_item(const Frame& F, const P2Ptrs& T, int b) {
    const int lane = F.lane;
    float mu[4], rs[4];
    {
        const f32x2v pr = *(const f32x2v*)(T.stats + ((size_t)(SEQ + b * 4 + (lane >> 4)) * 16 + (lane & 15)) * 2);
        float s1 = pr.x, s2 = pr.y;
#pragma unroll
        for (int o = 1; o < 16; o <<= 1) { s1 += __shfl_xor(s1, o); s2 += __shfl_xor(s2, o); }
        const float m_ = s1 * (1.0f / DA), var = fmaxf(s2 * (1.0f / DA) - m_ * m_, 0.f), r_ = 1.0f / sqrtf(var + EPS);
#pragma unroll
        for (int t = 0; t < 4; ++t) { mu[t] = __shfl(m_, 16 * t); rs[t] = __shfl(r_, 16 * t); }
    }
#pragma unroll 1
    for (int hh = 0; hh < 2; ++hh) {
        const int ch = hh * 512 + lane * 8, gi = ch >> 7;
        float lg[8], lb[8];
#pragma unroll
        for (int e = 0; e < 8; ++e) { lg[e] = T.ln_g[ch + e]; lb[e] = T.ln_b[ch + e]; }
        float vn[4][8];
#pragma unroll
        for (int t = 0; t < 4; ++t) {
            const size_t row = (size_t)(SEQ + b * 4 + t);
            const v4u gv = *(const v4u*)(T.GV + row * DA + ch);
            const unsigned wv[4] = {gv.x, gv.y, gv.z, gv.w};
#pragma unroll
            for (int e = 0; e < 4; ++e) { vn[t][2 * e] = (bflo(wv[e]) - mu[t]) * rs[t] * lg[2 * e] + lb[2 * e]; vn[t][2 * e + 1] = (bfhi(wv[e]) - mu[t]) * rs[t] * lg[2 * e + 1] + lb[2 * e + 1]; }
            float* vo = T.vc_out + (size_t)(b * 4 + t) * DA + ch;
            *(f32x4*)vo = (f32x4){vn[t][0], vn[t][1], vn[t][2], vn[t][3]}; *(f32x4*)(vo + 4) = (f32x4){vn[t][4], vn[t][5], vn[t][6], vn[t][7]};
        }
#pragma unroll
        for (int t = 0; t < 4; ++t) {
            const size_t row = (size_t)(SEQ + b * 4 + t);
            float mix[8];
            const float bias = T.b_s[gi * 128 + t];
#pragma unroll
            for (int e = 0; e < 8; ++e) mix[e] = bias;
#pragma unroll
            for (int s = 0; s < 4; ++s) if (s <= t) { const float wts = T.w_s[(size_t)(gi * 128 + t) * 128 + s];
#pragma unroll
                for (int e = 0; e < 8; ++e) mix[e] += wts * vn[s][e]; }
            const v4u uv = *(const v4u*)(T.U + row * DA + ch), gb = *(const v4u*)(T.GB + row * DA + ch);
            v4u o;
            o.x = cvtpk(bflo(uv.x) * mix[0] * bflo(gb.x), bfhi(uv.x) * mix[1] * bfhi(gb.x)); o.y = cvtpk(bflo(uv.y) * mix[2] * bflo(gb.y), bfhi(uv.y) * mix[3] * bfhi(gb.y));
            o.z = cvtpk(bflo(uv.z) * mix[4] * bflo(gb.z), bfhi(uv.z) * mix[5] * bfhi(gb.z)); o.w = cvtpk(bflo(uv.w) * mix[6] * bflo(gb.w), bfhi(uv.w) * mix[7] * bfhi(gb.w));
            *(v4u*)(T.AC + row * DM + DA + ch) = o;
        }
    }
}

__device__ __forceinline__ void p2_mixers(const Frame& F, const P2Ptrs& T) {
    {
        const int gt = (F.vcu * NWAVES + F.wave) * 64 + F.lane, NGT = F.G * NWAVES * 64;
        v4u z; z.x = 0u; z.y = 0u; z.z = 0u; z.w = 0u;
        for (int e = gt; e < (MP - MROWS) * DM / 8; e += NGT) *(v4u*)(T.AC + (size_t)MROWS * DM + (size_t)e * 8) = z;
    }
    for (int it = F.vcu; it < 512; it += F.G) attn_item(F, T, it >> 5, (it & 31) * 256);
    for (int it = F.vcu; it < 512; it += F.G) gmlp_item(F, T, it >> 3, it & 7);
    const int gw = F.vcu * NWAVES + F.wave, NGW = F.G * NWAVES;
    for (int si = gw; si < 2048; si += NGW) sattn_item(F, T, si);
    for (int b = gw; b < 32; b += NGW) sgmlp_item(F, T, b);
}

__device__ __forceinline__ void p4_final(const Frame& F, float* out, const float* ssq, const float* fg) {
    const int gw = F.vcu * NWAVES + F.wave, NGW = F.G * NWAVES, lane = F.lane;
    f32x4 gv[8];
#pragma unroll
    for (int j = 0; j < 8; ++j) gv[j] = *((const f32x4*)fg + 64 * j + lane);
    for (int m = gw; m < MROWS; m += NGW) {
        float s = lane < 32 ? ssq[(size_t)m * 32 + lane] : 0.f;
        s = wave_sum(s);
        const float r = 1.0f / sqrtf(s * (1.0f / DM) + EPS);
        f32x4* yr = (f32x4*)(out + (size_t)m * DM) + lane;
#pragma unroll
        for (int j = 0; j < 8; ++j) { const f32x4 v = yr[64 * j]; yr[64 * j] = v * r * gv[j]; }
    }
}

__global__ void __launch_bounds__(NWAVES * 64, 2) hybrid_fwd(Args args) {
    extern __shared__ __attribute__((aligned(16))) unsigned char lds[];
    Frame F;
    F.lds = (LAS unsigned char*)lds;
    F.tid = threadIdx.x; F.lane = F.tid & 63; F.wave = __builtin_amdgcn_readfirstlane(F.tid >> 6);
    F.G = gridDim.x; { const int bx = blockIdx.x; F.vcu = (F.G % 8 == 0) ? (bx % 8) * (F.G / 8) + bx / 8 : bx; }
    unsigned char* ws = args.ws;
    volatile LAS unsigned* MISC = (volatile LAS unsigned*)(F.lds + MISC_OFF);
    if (F.tid < 64) MISC[F.tid] = 0u;
    __syncthreads();
    XcdBarrier bar = xcd_barrier_post((unsigned*)(ws + WS_CTL) + CW_BAR, MISC + 8);

    p0_prologue(F, args);
    xcd_barrier(bar);

    {
        pg8::Gemm g{(const pg8::bf16_t*)(ws + WS_XN), (const pg8::bf16_t*)(ws + WS_WIN), MP, DIN, DM};
        pg8::StaticOrder S; S.init(MP, DIN, F.G, (int)blockIdx.x);
        EpiIn E{(bf16*)(ws + WS_Q), (bf16*)(ws + WS_K), (bf16*)(ws + WS_V), (bf16*)(ws + WS_GA), (bf16*)(ws + WS_U), (bf16*)(ws + WS_GV), (bf16*)(ws + WS_GB),
                (const float*)(ws + WS_ROPE), (float*)(ws + WS_STATS), args.out, (float*)(ws + WS_QS)};
        pg8::gemm_phase<EpiIn, pg8::StaticOrder, true, true>(F.lds, g, S, E);
    }
    xcd_barrier(bar);

    {
        P2Ptrs T{(const bf16*)(ws + WS_Q), (const bf16*)(ws + WS_K), (const bf16*)(ws + WS_V), (const bf16*)(ws + WS_GA), (const bf16*)(ws + WS_U), (const bf16*)(ws + WS_GV), (const bf16*)(ws + WS_GB),
                 (const bf16*)(ws + WS_WMP), (const float*)(ws + WS_STATS), (bf16*)(ws + WS_AC), args.in[2], args.in[3], args.out + OFF_KS, args.out + OFF_VS, (const float*)(ws + WS_QS),
                 args.in[6], args.in[7], args.in[8], args.in[9], args.out + OFF_VC};
        p2_mixers(F, T);
    }
    xcd_barrier(bar);

    {
        pg8::Gemm g{(const pg8::bf16_t*)(ws + WS_AC), (const pg8::bf16_t*)(ws + WS_WOUT), MP, DM, DM};
        pg8::StaticOrder S; S.init(MP, DM, F.G, (int)blockIdx.x);
        EpiOut E{args.in[0], args.in[1], args.out, (float*)(ws + WS_SS)};
        pg8::gemm_phase<EpiOut, pg8::StaticOrder, true, true>(F.lds, g, S, E);
    }
    xcd_barrier(bar);

    p4_final(F, args.out, (const float*)(ws + WS_SS), args.in[11]);
}

extern "C" void kernel_launch(void* const* d_in, const int* in_sizes, int n_in, void* d_out, int out_size, void* d_ws, size_t ws_size, hipStream_t stream) {
    static int grid = 0;
    if (grid == 0) {
        if (n_in != 12 || out_size != (int)OUT_TOTAL || ws_size < WS_END) { fprintf(stderr, "kernel_launch: unexpected shapes (n_in %d out %d ws %zu)\n", n_in, out_size, ws_size); grid = -1; return; }
        int dev = 0, cus = 0, per_cu = 0;
        if (hipGetDevice(&dev) != hipSuccess || hipDeviceGetAttribute(&cus, hipDeviceAttributeMultiprocessorCount, dev) != hipSuccess) { grid = -1; return; }
        if (hipFuncSetAttribute((const void*)hybrid_fwd, hipFuncAttributeMaxDynamicSharedMemorySize, LDS_BYTES) != hipSuccess) { fprintf(stderr, "kernel_launch: hipFuncSetAttribute failed\n"); grid = -1; return; }
        if (hipOccupancyMaxActiveBlocksPerMultiprocessor(&per_cu, (const void*)hybrid_fwd, NWAVES * 64, LDS_BYTES) != hipSuccess || per_cu < 1) { fprintf(stderr, "kernel_launch: occupancy query reports %d blocks per CU\n", per_cu); (void)hipGetLastError(); grid = -1; return; }
        grid = cus;
    }
    if (grid < 0) return;
    if (hipMemsetAsync((char*)d_ws + WS_CTL, 0, CTL_ZERO_BYTES, stream) != hipSuccess) return;
    Args a{};
    for (int i = 0; i < 12; ++i) a.in[i] = (const float*)d_in[i];
    a.out = (float*)d_out; a.ws = (unsigned char*)d_ws;
    for (int i = 0; i < 32; ++i) a.invf[i] = exp(-log(10000.0) * (double)i / 32.0);
    hipLaunchKernelGGL(hybrid_fwd, dim3(grid), dim3(NWAVES * 64), LDS_BYTES, stream, a);
}
```

```cpp
#include <hip/hip_runtime.h>
#include <cstdio>
#include <cstdint>
#include <cmath>

namespace pg8 {
#define PG8_LAS __attribute__((address_space(3)))
typedef unsigned short bf16_t;
typedef short bf16x8 __attribute__((ext_vector_type(8)));
typedef float f32x4 __attribute__((ext_vector_type(4)));
typedef unsigned u32x4 __attribute__((ext_vector_type(4)));
constexpr int BM = 256, BK = 64, HALF = 128, HTB = HALF * BK * 2  , STAGE_BYTES = 8 * HTB, NXCD = 8, WGM = 8;

__host__ __device__ __forceinline__ int lds_byte(int r, int c) { const int st = (r >> 4) * 2 + (c >> 5), rr = r & 15, cc = c & 31, ob = rr * 64 + cc * 2; return st * 1024 + (ob ^ (((ob >> 9) & 1) << 5)); }
__host__ __device__ __forceinline__ void stage_rc(int b, int& R, int& C) { const int st = b / 1024, sb = b % 1024, swz = sb ^ (((sb >> 9) & 1) << 5); R = (st >> 1) * 16 + swz / 64; C = (st & 1) * 32 + (swz % 64) / 2; }
__host__ __device__ __forceinline__ int perm32(int rho) { const int n = rho >> 4, i = rho & 15; return 8 * (i >> 2) + 4 * n + (i & 3); }

struct Unit { int pm, pn; };
struct Gemm { const bf16_t* A; const bf16_t* Bt; int M, N, K; };

struct StaticOrder {
    int nM, nN, nwg, G, c;
    __host__ __device__ void init(int M, int N, int G_, int c_) { nM = M / BM; nN = N / BM; nwg = nM * nN; G = G_; c = c_; }
    __host__ __device__ bool next(int i, Unit& u) const {
        const long L = (long)i * G + c; if (L >= nwg) return false;
        int wgid = (int)L; { const int q = nwg / NXCD, r = nwg % NXCD, xcd = wgid % NXCD, off = wgid / NXCD; wgid = (xcd < r ? xcd * (q + 1) : r * (q + 1) + (xcd - r) * q) + off; }
        const int nig = WGM * nN, gid = wgid / nig, fm = gid * WGM, gsz = (nM - fm) < WGM ? (nM - fm) : WGM;
        u.pm = fm + ((wgid % nig) % gsz); u.pn = (wgid % nig) / gsz; return true;
    }
    __device__ __forceinline__ void a_ready(const Unit&) const {}
    __device__ __forceinline__ void done(const Unit&) const {}
};
__device__ __forceinline__ unsigned cvt_pk_bf16(float lo, float hi) { unsigned r; asm volatile("v_cvt_pk_bf16_f32 %0, %1, %2" : "=v"(r) : "v"(lo), "v"(hi)); return r; }
template <class Epi, class Sched, bool ALIGN_EPI = false, bool SP2 = false>
__device__ __forceinline__ void gemm_phase(PG8_LAS unsigned char* lds, const Gemm g, const Sched& S, const Epi& E) {
    const int tid = threadIdx.x, wid = __builtin_amdgcn_readfirstlane(tid >> 6), lane = tid & 63, wr = wid >> 2, wc = wid & 3, fr = lane & 15, fq = lane >> 4;
    const int K = g.K, nt = K / BK;
    unsigned voffA[2], voffB[2];
#pragma unroll
    for (int i = 0; i < 2; ++i) { int R, C; stage_rc(tid * 16 + i * 8192, R, C); const int Rb = Epi::PERM ? ((R & ~31) + perm32(R & 31)) : R;
        voffA[i] = (unsigned)(R * K + C) * 2u; voffB[i] = (unsigned)(Rb * K + C) * 2u; }
    const size_t kstep = (size_t)(BK * 2);
    const size_t hstep = (size_t)HALF * K * 2;
    const size_t tstep = 2 * hstep;
    const unsigned ldsw = (unsigned)wid * 1024u;
    const int aoff = lds_byte(wr * 64 + fr, fq * 8), boff = lds_byte(wc * 32 + fr, fq * 8);
#define PG8_SA(b, h) (((b) * 2 + (h)) * HTB)
#define PG8_SB(b, h) ((4 + (b) * 2 + (h)) * HTB)
#define PG8_STAGE(bufoff, gbase, voff) do { _Pragma("unroll") for (int _i = 0; _i < 2; ++_i) \
        __builtin_amdgcn_global_load_lds((const unsigned*)((const char*)(gbase) + (voff)[_i]), (PG8_LAS unsigned*)(lds + (bufoff) + ldsw + _i * 8192), 16, 0, 0); } while (0)
#define PG8_LDA(dst, b, h) do { _Pragma("unroll") for (int m = 0; m < 4; ++m) _Pragma("unroll") for (int k = 0; k < 2; ++k) dst[m][k] = *(const PG8_LAS bf16x8*)(lds + PG8_SA(b, h) + aoff + m * 2048 + k * 1024); } while (0)
#define PG8_LDB(dst, b, h) do { _Pragma("unroll") for (int n = 0; n < 2; ++n) _Pragma("unroll") for (int k = 0; k < 2; ++k) dst[n][k] = *(const PG8_LAS bf16x8*)(lds + PG8_SB(b, h) + boff + n * 2048 + k * 1024); } while (0)
#define PG8_MMA(ai, bj, At, Bt) do { __builtin_amdgcn_s_setprio(1); _Pragma("unroll") for (int m = 0; m < 4; ++m) _Pragma("unroll") for (int n = 0; n < 2; ++n) _Pragma("unroll") for (int k = 0; k < 2; ++k) \
        acc[ai][bj][m][n] = __builtin_amdgcn_mfma_f32_16x16x32_bf16(Bt[n][k], At[m][k], acc[ai][bj][m][n], 0, 0, 0); __builtin_amdgcn_s_setprio(0); } while (0)
#define PG8_WAIT_V(n) asm volatile("s_waitcnt vmcnt(" #n ")" ::: "memory")
#define PG8_WAIT_L(n) asm volatile("s_waitcnt lgkmcnt(" #n ")" ::: "memory")
#define PG8_BAR __builtin_amdgcn_s_barrier()
#define PG8_SCHED __builtin_amdgcn_sched_barrier(0)
    Unit cur, nxt; int ui = 0;
    if (!S.next(0, cur)) return;
    f32x4 acc[2][2][4][2];
#pragma unroll
    for (int a = 0; a < 2; ++a)
#pragma unroll
        for (int b = 0; b < 2; ++b)
#pragma unroll
            for (int m = 0; m < 4; ++m)
#pragma unroll
                for (int n = 0; n < 2; ++n) acc[a][b][m][n] = (f32x4){0.f, 0.f, 0.f, 0.f};
    bf16x8 At[4][2], B0[2][2], B1[2][2];
    const char* cA = (const char*)g.A + (size_t)cur.pm * tstep; const char* cB = (const char*)g.Bt + (size_t)cur.pn * tstep;
    S.a_ready(cur);
    if constexpr (SP2) {
        PG8_STAGE(PG8_SB(0, 0), cB, voffB); PG8_STAGE(PG8_SB(0, 1), cB + hstep, voffB); PG8_STAGE(PG8_SA(0, 0), cA, voffA); PG8_STAGE(PG8_SA(0, 1), cA + hstep, voffA);
        if (wr == 1) PG8_BAR;
        PG8_WAIT_V(2); PG8_BAR;
        PG8_STAGE(PG8_SB(1, 0), cB + kstep, voffB); PG8_STAGE(PG8_SA(1, 0), cA + kstep, voffA); PG8_STAGE(PG8_SB(1, 1), cB + hstep + kstep, voffB);
        PG8_WAIT_V(6); PG8_BAR;
    } else {
        PG8_STAGE(PG8_SB(0, 0), cB, voffB); PG8_STAGE(PG8_SA(0, 0), cA, voffA); PG8_STAGE(PG8_SB(0, 1), cB + hstep, voffB); PG8_STAGE(PG8_SA(0, 1), cA + hstep, voffA);
        if (wr == 1) PG8_BAR;
        PG8_WAIT_V(4); PG8_BAR;
        PG8_STAGE(PG8_SB(1, 0), cB + kstep, voffB); PG8_STAGE(PG8_SA(1, 0), cA + kstep, voffA); PG8_STAGE(PG8_SB(1, 1), cB + hstep + kstep, voffB);
        PG8_WAIT_V(6); PG8_BAR;
    }
    for (;;) {
        const bool has_next = S.next(ui + 1, nxt);
        const char* nA = has_next ? (const char*)g.A + (size_t)nxt.pm * tstep : cA; const char* nB = has_next ? (const char*)g.Bt + (size_t)nxt.pn * tstep : cB;
        for (int t = 0; t < nt; t += 2) {
            const bool last = (t == nt - 2);
            const char* a1 = cA + (size_t)(t + 1) * kstep;
            const char* a2 = last ? nA : cA + (size_t)(t + 2) * kstep; const char* b2 = last ? nB : cB + (size_t)(t + 2) * kstep;
            const char* a3 = a2 + kstep; const char* b3 = b2 + kstep;
            if (last && has_next) S.a_ready(nxt);
            if constexpr (SP2) {
            PG8_LDB(B0, 0, 0); PG8_LDB(B1, 0, 1); PG8_SCHED; PG8_LDA(At, 0, 0); PG8_STAGE(PG8_SA(1, 1), a1 + hstep, voffA);
            PG8_WAIT_V(8); PG8_WAIT_L(0); PG8_BAR; PG8_MMA(0, 0, At, B0); PG8_MMA(0, 1, At, B1); PG8_BAR; PG8_SCHED;
            PG8_LDA(At, 0, 1); PG8_STAGE(PG8_SB(0, 0), b2, voffB); PG8_STAGE(PG8_SB(0, 1), b2 + hstep, voffB); PG8_STAGE(PG8_SA(0, 0), a2, voffA);
            PG8_WAIT_V(8); PG8_WAIT_L(0); PG8_BAR; PG8_MMA(1, 0, At, B0); PG8_MMA(1, 1, At, B1); PG8_BAR; PG8_SCHED;
            PG8_LDB(B0, 1, 0); PG8_LDB(B1, 1, 1); PG8_SCHED; PG8_LDA(At, 1, 0); PG8_STAGE(PG8_SA(0, 1), a2 + hstep, voffA);
            PG8_WAIT_V(8); PG8_WAIT_L(0); PG8_BAR; PG8_MMA(0, 0, At, B0); PG8_MMA(0, 1, At, B1); PG8_BAR; PG8_SCHED;
            PG8_LDA(At, 1, 1); PG8_STAGE(PG8_SB(1, 0), b3, voffB); PG8_STAGE(PG8_SB(1, 1), b3 + hstep, voffB); PG8_STAGE(PG8_SA(1, 0), a3, voffA);
            PG8_WAIT_V(8); PG8_WAIT_L(0); PG8_BAR; PG8_MMA(1, 0, At, B0); PG8_MMA(1, 1, At, B1); PG8_BAR; PG8_SCHED;
            } else {
            PG8_LDB(B0, 0, 0); PG8_SCHED; PG8_LDA(At, 0, 0); PG8_STAGE(PG8_SA(1, 1), a1 + hstep, voffA);
            PG8_WAIT_L(8); PG8_BAR; PG8_WAIT_L(0); PG8_MMA(0, 0, At, B0); PG8_BAR; PG8_SCHED;
            PG8_LDB(B1, 0, 1); PG8_STAGE(PG8_SB(0, 0), b2, voffB);
            PG8_BAR; PG8_WAIT_L(0); PG8_MMA(0, 1, At, B1); PG8_BAR;
            PG8_LDA(At, 0, 1); PG8_STAGE(PG8_SA(0, 0), a2, voffA);
            PG8_BAR; PG8_WAIT_L(0); PG8_MMA(1, 0, At, B0); PG8_BAR; PG8_SCHED;
            PG8_STAGE(PG8_SB(0, 1), b2 + hstep, voffB);
            PG8_WAIT_V(6); PG8_BAR; PG8_MMA(1, 1, At, B1); PG8_BAR;
            PG8_LDB(B0, 1, 0); PG8_SCHED; PG8_LDA(At, 1, 0); PG8_STAGE(PG8_SA(0, 1), a2 + hstep, voffA);
            PG8_WAIT_L(8); PG8_BAR; PG8_WAIT_L(0); PG8_MMA(0, 0, At, B0); PG8_BAR; PG8_SCHED;
            PG8_LDB(B1, 1, 1); PG8_STAGE(PG8_SB(1, 0), b3, voffB);
            PG8_BAR; PG8_WAIT_L(0); PG8_MMA(0, 1, At, B1); PG8_BAR;
            PG8_LDA(At, 1, 1); PG8_STAGE(PG8_SA(1, 0), a3, voffA);
            PG8_BAR; PG8_WAIT_L(0); PG8_MMA(1, 0, At, B0); PG8_BAR; PG8_SCHED;
            PG8_STAGE(PG8_SB(1, 1), b3 + hstep, voffB);
            PG8_WAIT_V(6); PG8_BAR; PG8_MMA(1, 1, At, B1); PG8_BAR;
            }
        }
        if constexpr (ALIGN_EPI) { if (wr == 0) PG8_BAR; }
        if constexpr (!Epi::AFTER_DRAIN) { E(acc, cur, wr, wc, fr, fq); S.done(cur); }
        if (!has_next) break;
#pragma unroll
        for (int a = 0; a < 2; ++a)
#pragma unroll
            for (int b = 0; b < 2; ++b)
#pragma unroll
                for (int m = 0; m < 4; ++m)
#pragma unroll
                    for (int n = 0; n < 2; ++n) acc[a][b][m][n] = (f32x4){0.f, 0.f, 0.f, 0.f};
        cur = nxt; cA = nA; cB = nB; ++ui;
        if constexpr (ALIGN_EPI) { if (wr == 1) PG8_BAR; }
    }
    PG8_WAIT_V(0);
    if constexpr (!ALIGN_EPI) { if (wr == 0) PG8_BAR; }
    PG8_BAR;
    if constexpr (Epi::AFTER_DRAIN) { E.fused(acc, cur, wr, wc, fr, fq, lds, wid, lane); S.done(cur); }
#undef PG8_SA
#undef PG8_SB
#undef PG8_STAGE
#undef PG8_LDA
#undef PG8_LDB
#undef PG8_MMA
#undef PG8_WAIT_V
#undef PG8_WAIT_L
#undef PG8_BAR
#undef PG8_SCHED
}
}

#ifndef REP_P0
#define REP_P0 1
#endif
#ifndef REP_P1
#define REP_P1 1
#endif
#ifndef REP_ATT
#define REP_ATT 1
#endif
#ifndef REP_GMLP
#define REP_GMLP 1
#endif
#ifndef REP_SATT
#define REP_SATT 1
#endif
#ifndef REP_P3
#define REP_P3 1
#endif

constexpr int NWAVES = 8;
constexpr int DM = 2048, SEQ = 8192, NSAMP = 128, MROWS = SEQ + NSAMP  , MP = 8448  , DIN = 7168, DA = 1024, NHEAD = 16, HDIM = 64;
constexpr int WBUF = 2048, TAIL0 = SEQ - 2048, PAST = 16384, NSLOT = SEQ + 4;
constexpr float EPS = 1e-6f;
constexpr float QSCALE = 0.125f * 1.4426950408889634f;
constexpr size_t OFF_YP = 0, OFF_YS = 16777216, OFF_KT = 17039360, OFF_VT = 19136512, OFF_KS = 21233664, OFF_VS = 21364736, OFF_VC = 21495808, OUT_TOTAL = 21626880;

constexpr size_t MiB = 1u << 20;
constexpr size_t WS_CTL = 0, CTL_ZERO_BYTES = 1 * MiB;
constexpr size_t WS_WIN = 2 * MiB, WS_WOUT = 30 * MiB, WS_XN = 38 * MiB, WS_ROPE = 71 * MiB;
constexpr int PADR = 2304;
constexpr size_t WS_Q = 74 * MiB, WS_K = 91 * MiB, WS_V = 112 * MiB, WS_GA = 133 * MiB, WS_U = 150 * MiB, WS_GV = 167 * MiB, WS_GB = 184 * MiB;
constexpr size_t WS_STATS = 201 * MiB, WS_AC = 203 * MiB, WS_SS = 236 * MiB, WS_WMP = 238 * MiB, WS_QS = 239 * MiB, WS_END = 240 * MiB;
static_assert((size_t)(MP + PADR) * DA * 2 <= 21 * MiB, "K / V with padding rows");
constexpr int CW_BAR = 4096;

constexpr int LDS_BYTES = 147456;
constexpr int MISC_OFF = LDS_BYTES - 256;
constexpr int ACC_STRIDE = 68;
constexpr int L_ACC = 0, L_ML = 256 * ACC_STRIDE * 4  , L_VB = L_ML + 2048  , L_END_ATT = L_VB + NWAVES * 8192;
static_assert(L_END_ATT <= MISC_OFF, "LDS map");

#define GAS __attribute__((address_space(1)))
#define LAS __attribute__((address_space(3)))
typedef unsigned short bf16;
typedef unsigned v4u __attribute__((ext_vector_type(4)));
typedef float f32x4 __attribute__((ext_vector_type(4)));
typedef short bf16x8 __attribute__((ext_vector_type(8)));
typedef GAS unsigned gu32;
typedef GAS unsigned long long gu64;
#define RLX_AGENT __ATOMIC_RELAXED, __HIP_MEMORY_SCOPE_AGENT
#define LDS_WAIT() asm volatile("s_waitcnt lgkmcnt(0)" ::: "memory")
#define VM_WAIT() asm volatile("s_waitcnt vmcnt(0)" ::: "memory")
__device__ __forceinline__ unsigned long long rt() { return __builtin_amdgcn_s_memrealtime(); }
__device__ __forceinline__ unsigned f2bf(float f) { unsigned u = __builtin_bit_cast(unsigned, f); return (u + 0x7fffu + ((u >> 16) & 1u)) >> 16; }
__device__ __forceinline__ unsigned pk2(float lo, float hi) { return f2bf(lo) | (f2bf(hi) << 16); }
#define XB_TMO      128
#define XB_XCNT(j)  (256  + 64 * (j))
#define XB_XSUB(j)  (1280 + 64 * (j))
#define XB_XGEN(j)  (2304 + 64 * (j))
#define XB_TOP      3328
#define XB_TOPGEN   3392
#define XCD_BAR_WORDS 3456
#define XB_SPIN_CAP (1u << 18)

__device__ __forceinline__ unsigned xb_ld(unsigned* p)              { return __hip_atomic_load(p, __ATOMIC_RELAXED, __HIP_MEMORY_SCOPE_AGENT); }
__device__ __forceinline__ unsigned xb_add(unsigned* p, unsigned v) { return __hip_atomic_fetch_add(p, v, __ATOMIC_RELAXED, __HIP_MEMORY_SCOPE_AGENT); }
__device__ __forceinline__ unsigned xb_xcc_id() { return (unsigned)__builtin_amdgcn_s_getreg((3 << 11) | 20) & 0xFu; }
#define XB_SPIN(cond, bar) do { unsigned _sp = 0; while (cond) { __builtin_amdgcn_s_sleep(1); \
    if ((++_sp & 255u) == 0u) { if (xb_ld(&(bar)[XB_TMO])) break; if (_sp > XB_SPIN_CAP) { atomicAdd(&(bar)[XB_TMO], 1u); break; } } } } while (0)

struct XcdBarrier {
    unsigned* bar; unsigned x;
    volatile LAS unsigned* st;
};

__device__ __forceinline__ XcdBarrier xcd_barrier_post(unsigned* bar, volatile LAS unsigned* st) {
    XcdBarrier b; b.bar = bar; b.x = xb_xcc_id(); b.st = st;
    if (threadIdx.x == 0) (void)xb_add(&bar[XB_XCNT(b.x)], 1u);
    return b;
}
__device__ __forceinline__ void xcd_barrier_complete(unsigned* bar, unsigned x, unsigned& nloc, unsigned& nx) {
    const unsigned G = gridDim.x * gridDim.y * gridDim.z;
    unsigned sum, cnt, mine, sp = 0u;
    for (;;) {
        sum = 0u; cnt = 0u; mine = 0u;
#pragma unroll
        for (unsigned j = 0; j < 16; ++j) { const unsigned c = xb_ld(&bar[XB_XCNT(j)]); sum += c; cnt += (c > 0u) ? 1u : 0u; mine = (j == x) ? c : mine; }
        if (sum == G) break;
        __builtin_amdgcn_s_sleep(1);
        if ((++sp & 255u) == 0u) { if (xb_ld(&bar[XB_TMO])) break; if (sp > XB_SPIN_CAP) { atomicAdd(&bar[XB_TMO], 1u); break; } }
    }
    nloc = mine > 0u ? mine : 1u; nx = cnt > 0u ? cnt : 1u;
}

__device__ __forceinline__ void xcd_barrier(const XcdBarrier& b) {
    asm volatile("s_waitcnt vmcnt(0)" ::: "memory");
    __syncthreads();
    if (threadIdx.x == 0) {
        unsigned* bar = b.bar;
        __builtin_amdgcn_s_waitcnt(0);
        unsigned nloc = b.st[0], nx = b.st[1];
        if (nloc == 0u) { xcd_barrier_complete(bar, b.x, nloc, nx); b.st[0] = nloc; b.st[1] = nx; }
        const unsigned old = xb_add(&bar[XB_XSUB(b.x)], 1u);
        const unsigned gen = old / nloc;
        if (old + 1u == (gen + 1u) * nloc) {
            __builtin_amdgcn_fence(__ATOMIC_RELEASE, "agent");
            asm volatile("s_waitcnt vmcnt(0)" ::: "memory");
            const unsigned og = xb_add(&bar[XB_TOP], 1u);
            const unsigned tg = og / nx;
            if (og + 1u == (tg + 1u) * nx) xb_add(&bar[XB_TOPGEN], 1u);
            else XB_SPIN(xb_ld(&bar[XB_TOPGEN]) == tg, bar);
            __builtin_amdgcn_fence(__ATOMIC_ACQUIRE, "agent");
            xb_add(&bar[XB_XGEN(b.x)], 1u);
            asm volatile("s_waitcnt vmcnt(0)" ::: "memory");
        } else {
            XB_SPIN(xb_ld(&bar[XB_XGEN(b.x)]) == gen, bar);
            __builtin_amdgcn_fence(__ATOMIC_ACQUIRE, "agent");
            asm volatile("s_waitcnt vmcnt(0)" ::: "memory");
        }
    }
    __syncthreads();
}

struct Frame {
    LAS unsigned char* lds;
    int tid, lane, wave, vcu, G;
};
struct Args { const float* in[12]; float* out; unsigned char* ws; double invf[32]; };

typedef float f32x2v __attribute__((ext_vector_type(2)));
typedef unsigned u32x2v __attribute__((ext_vector_type(2)));
typedef short s16x4 __attribute__((ext_vector_type(4)));

__device__ __forceinline__ float wave_sum(float v) {
#pragma unroll
    for (int o = 1; o < 64; o <<= 1) v += __shfl_xor(v, o);
    return v;
}
__device__ __forceinline__ unsigned cvtpk(float lo, float hi) { return pg8::cvt_pk_bf16(lo, hi); }
__device__ __forceinline__ float bf2f(unsigned short b) { return __builtin_bit_cast(float, (unsigned)b << 16); }
__device__ __forceinline__ float bflo(unsigned w) { return __builtin_bit_cast(float, w << 16); }
__device__ __forceinline__ float bfhi(unsigned w) { return __builtin_bit_cast(float, w & 0xffff0000u); }
__device__ __forceinline__ float xsig(float x, float z) { return x * __builtin_amdgcn_rcpf(1.0f + __builtin_amdgcn_exp2f(-1.4426950408889634f * z)); }
__device__ __forceinline__ float silu_f(float x) { return xsig(x, x); }
__device__ __forceinline__ float gelu_f(float x) { return xsig(x, 1.5957691216057308f * (x + 0.044715f * x * x * x)); }

__device__ __forceinline__ int dest_row_in(int n) { if (n >= 2 * DA) return n; const int l = n & 63, hb = n & ~63; return hb + (l < 32 ? 2 * l : 2 * (l - 32) + 1); }
__device__ __forceinline__ void p0_transpose_item(const float* W, int K, int N, bf16* WT, const float* gk, bool perm, LAS float* scr, int item, int lane) {
    const int nblk = N / 32, kb = item / nblk, nb = item % nblk, k0 = 64 * kb, n0 = 32 * nb;
#pragma unroll 8
    for (int i = 0; i < 32; ++i) { const int kk = 2 * i + (lane >> 5); float w = W[(size_t)(k0 + kk) * N + n0 + (lane & 31)]; if (gk) w *= gk[k0 + kk]; scr[kk * 33 + (lane & 31)] = w; }
    LDS_WAIT(); asm volatile("" ::: "memory");
    const int c = lane & 7;
#pragma unroll
    for (int j = 0; j < 4; ++j) { const int n = (lane >> 3) + 8 * j; const LAS float* s = scr + (8 * c) * 33 + n;
        v4u o; o.x = pk2(s[0 * 33], s[1 * 33]); o.y = pk2(s[2 * 33], s[3 * 33]); o.z = pk2(s[4 * 33], s[5 * 33]); o.w = pk2(s[6 * 33], s[7 * 33]);
        const int dr = perm ? dest_row_in(n0 + n) : (n0 + n);
        *(GAS v4u*)(WT + (size_t)dr * K + k0 + 8 * c) = o; }
    LDS_WAIT(); asm volatile("" ::: "memory");
}
__device__ __forceinline__ void rms_row_to_bf16(int lane, const float* xrow, bf16* orow) {
    GAS unsigned long long* o8 = (GAS unsigned long long*)orow + lane;
    if (xrow == nullptr) {
#pragma unroll
        for (int j = 0; j < 8; ++j) o8[64 * j] = 0ull;
        return;
    }
    const GAS f32x4* xr = (const GAS f32x4*)xrow + lane;
    f32x4 v[8]; float s = 0.f;
#pragma unroll
    for (int j = 0; j < 8; ++j) { v[j] = xr[64 * j]; s += (v[j].x * v[j].x + v[j].y * v[j].y) + (v[j].z * v[j].z + v[j].w * v[j].w); }
    const float r = 1.0f / sqrtf(wave_sum(s) * (1.0f / DM) + EPS);
#pragma unroll
    for (int j = 0; j < 8; ++j) o8[64 * j] = (unsigned long long)pk2(v[j].x * r, v[j].y * r) | ((unsigned long long)pk2(v[j].z * r, v[j].w * r) << 32);
}
__device__ __forceinline__ void p0_prologue(const Frame& F, const Args& A) {
    unsigned char* ws = A.ws;
    LAS float* scr = (LAS float*)(F.lds + F.wave * 16384);
    const int gw = F.vcu * NWAVES + F.wave, NGW = F.G * NWAVES;
    constexpr int I_IN = (DM / 64) * (DIN / 32), I_OUT = (DM / 64) * (DM / 32);
    for (int it = gw; it < I_IN + I_OUT; it += NGW) {
        if (it < I_IN) p0_transpose_item(A.in[5], DM, DIN, (bf16*)(ws + WS_WIN), A.in[4], true, scr, it, F.lane);
        else p0_transpose_item(A.in[10], DM, DM, (bf16*)(ws + WS_WOUT), nullptr, false, scr, it - I_IN, F.lane);
    }
    for (int m = gw; m < MP; m += NGW) {
        const float* xrow = m < SEQ ? A.in[0] + (size_t)m * DM : (m < MROWS ? A.in[1] + (size_t)(m - SEQ) * DM : nullptr);
        rms_row_to_bf16(F.lane, xrow, (bf16*)(ws + WS_XN) + (size_t)m * DM);
    }
    const int gt = gw * 64 + F.lane, NGT = NGW * 64;
    float* rope = (float*)(ws + WS_ROPE);
    for (int e = gt; e < NSLOT * 32; e += NGT) {
        const int slot = e >> 5, i = e & 31;
        const int pos = slot < SEQ ? slot : PAST + (slot - SEQ);
        const double ang = (double)pos * A.invf[i];
        const double kq = rint(ang * 0.15915494309189535);
        double r = fma(-kq, 6.283185307179586, ang); r = fma(-kq, 2.4492935982947064e-16, r);
        const float rf = (float)r;
        f32x2v cs; cs.x = cosf(rf); cs.y = sinf(rf);
        *(f32x2v*)(rope + 2 * (size_t)e) = cs;
    }
    {
        v4u z; z.x = 0u; z.y = 0u; z.z = 0u; z.w = 0u;
        for (int e = gt; e < PADR * DA / 8; e += NGT) { *(v4u*)(ws + WS_K + (size_t)e * 16) = z; *(v4u*)(ws + WS_V + (size_t)e * 16) = z; }
    }
    bf16* wmp = (bf16*)(ws + WS_WMP);
    for (int e = gt; e < 8 * 128 * 128; e += NGT) {
        const int kp = e & 127, t = (e >> 7) & 127, g = e >> 14;
        const int ss = kp >> 5, q = (kp >> 3) & 3, j = kp & 7, s = 32 * ss + 16 * (j >> 2) + 4 * q + (j & 3);
        const float w = s <= t ? A.in[8][(size_t)(g * 128 + t) * 128 + s] : 0.f;
        wmp[e] = (bf16)f2bf(w);
    }
}

struct EpiIn {
    static constexpr bool PERM = true, AFTER_DRAIN = false;
    bf16 *Q, *K, *V, *GA, *U, *GV, *GB;
    const float* rope; float* stats; float* out; float* qs;
    __device__ __forceinline__ void operator()(const pg8::f32x4 (&acc)[2][2][4][2], const pg8::Unit& u, int wr, int wc, int fr, int fq) const {
        const int sec = u.pn >> 2;
        const int col0 = (u.pn & 3) * 256 + wc * 32 + 8 * fq;
        const int row0 = u.pm * 256 + wr * 64 + fr;
        if (sec <= 1) {
            bf16* dstb = sec == 0 ? Q : K;
            const float sc = sec == 0 ? QSCALE : 1.0f;
#pragma unroll
            for (int ai = 0; ai < 2; ++ai)
#pragma unroll
                for (int m = 0; m < 4; ++m) {
                    const int row = row0 + ai * 128 + m * 16;
                    const int slot = row < SEQ ? row : SEQ + ((row - SEQ) & 3);
                    float* fdst = nullptr;
                    if (sec == 1) { if (row >= TAIL0 && row < SEQ) fdst = out + OFF_KT + (size_t)(row - TAIL0) * DA; else if (row >= SEQ && row < MROWS) fdst = out + OFF_KS + (size_t)(row - SEQ) * DA; }
                    else { if (row >= SEQ && row < MROWS) fdst = qs + (size_t)(row - SEQ) * DA; }
#pragma unroll
                    for (int bj = 0; bj < 2; ++bj) {
                        const int cl = col0 + bj * 128, hb = cl & ~63, i0 = (cl & 63) >> 1;
                        const float* tp = rope + ((size_t)slot * 32 + i0) * 2;
                        const f32x4 t0 = *(const f32x4*)tp, t1 = *(const f32x4*)(tp + 4);
                        const f32x4 v0 = acc[ai][bj][m][0], v1 = acc[ai][bj][m][1];
                        f32x4 y1, y2;
                        y1[0] = (v0[0] * t0[0] - v0[1] * t0[1]) * sc; y2[0] = (v0[1] * t0[0] + v0[0] * t0[1]) * sc;
                        y1[1] = (v0[2] * t0[2] - v0[3] * t0[3]) * sc; y2[1] = (v0[3] * t0[2] + v0[2] * t0[3]) * sc;
                        y1[2] = (v1[0] * t1[0] - v1[1] * t1[1]) * sc; y2[2] = (v1[1] * t1[0] + v1[0] * t1[1]) * sc;
                        y1[3] = (v1[2] * t1[2] - v1[3] * t1[3]) * sc; y2[3] = (v1[3] * t1[2] + v1[2] * t1[3]) * sc;
                        v4u w; w.x = cvtpk(y1[0], y2[0]); w.y = cvtpk(y1[1], y2[1]); w.z = cvtpk(y1[2], y2[2]); w.w = cvtpk(y1[3], y2[3]);
                        *(v4u*)(dstb + (size_t)row * DA + cl) = w;
                        if (fdst) { *(f32x4*)(fdst + hb + i0) = y1; *(f32x4*)(fdst + hb + 32 + i0) = y2; }
                    }
                }
        } else if (sec == 2) {
#pragma unroll
            for (int ai = 0; ai < 2; ++ai)
#pragma unroll
                for (int m = 0; m < 4; ++m) {
                    const int row = row0 + ai * 128 + m * 16;
                    float* fdst = nullptr;
                    if (row >= TAIL0 && row < SEQ) fdst = out + OFF_VT + (size_t)(row - TAIL0) * DA; else if (row >= SEQ && row < MROWS) fdst = out + OFF_VS + (size_t)(row - SEQ) * DA;
#pragma unroll
                    for (int bj = 0; bj < 2; ++bj) {
                        const int cl = col0 + bj * 128;
                        const f32x4 v0 = acc[ai][bj][m][0], v1 = acc[ai][bj][m][1];
                        v4u w; w.x = cvtpk(v0[0], v0[1]); w.y = cvtpk(v0[2], v0[3]); w.z = cvtpk(v1[0], v1[1]); w.w = cvtpk(v1[2], v1[3]);
                        *(v4u*)(V + (size_t)row * DA + cl) = w;
                        if (fdst) { *(f32x4*)(fdst + cl) = v0; *(f32x4*)(fdst + cl + 4) = v1; }
                    }
                }
        } else if (sec == 3 || sec == 6) {
            bf16* dstb = sec == 3 ? GA : GB;
#pragma unroll
            for (int ai = 0; ai < 2; ++ai)
#pragma unroll
                for (int m = 0; m < 4; ++m) {
                    const int row = row0 + ai * 128 + m * 16;
#pragma unroll
                    for (int bj = 0; bj < 2; ++bj) {
                        const int cl = col0 + bj * 128;
                        const f32x4 v0 = acc[ai][bj][m][0], v1 = acc[ai][bj][m][1];
                        v4u w; w.x = cvtpk(silu_f(v0[0]), silu_f(v0[1])); w.y = cvtpk(silu_f(v0[2]), silu_f(v0[3])); w.z = cvtpk(silu_f(v1[0]), silu_f(v1[1])); w.w = cvtpk(silu_f(v1[2]), silu_f(v1[3]));
                        *(v4u*)(dstb + (size_t)row * DA + cl) = w;
                    }
                }
        } else {
            bf16* dstb = sec == 4 ? U : GV;
#pragma unroll
            for (int ai = 0; ai < 2; ++ai)
#pragma unroll
                for (int m = 0; m < 4; ++m) {
                    const int row = row0 + ai * 128 + m * 16;
                    float s1 = 0.f, s2 = 0.f;
#pragma unroll
                    for (int bj = 0; bj < 2; ++bj) {
                        const int cl = col0 + bj * 128;
                        f32x4 v0 = acc[ai][bj][m][0], v1 = acc[ai][bj][m][1];
#pragma unroll
                        for (int e = 0; e < 4; ++e) { v0[e] = gelu_f(v0[e]); v1[e] = gelu_f(v1[e]); s1 += v0[e] + v1[e]; s2 += v0[e] * v0[e] + v1[e] * v1[e]; }
                        v4u w; w.x = cvtpk(v0[0], v0[1]); w.y = cvtpk(v0[2], v0[3]); w.z = cvtpk(v1[0], v1[1]); w.w = cvtpk(v1[2], v1[3]);
                        *(v4u*)(dstb + (size_t)row * DA + cl) = w;
                    }
                    if (sec == 5) {
                        s1 += __shfl_xor(s1, 16); s1 += __shfl_xor(s1, 32); s2 += __shfl_xor(s2, 16); s2 += __shfl_xor(s2, 32);
                        if (fq == 0) { f32x2v p; p.x = s1; p.y = s2; *(f32x2v*)(stats + ((size_t)row * 16 + (u.pn & 3) * 4 + wc) * 2) = p; }
                    }
                }
        }
    }
};

struct EpiOut {
    static constexpr bool PERM = false, AFTER_DRAIN = false;
    const float* xp; const float* xs; float* out; float* ssq;
    __device__ __forceinline__ void operator()(const pg8::f32x4 (&acc)[2][2][4][2], const pg8::Unit& u, int wr, int wc, int fr, int fq) const {
        const int row0 = u.pm * 256 + wr * 64 + fr, col0 = u.pn * 256 + wc * 32 + 4 * fq;
#pragma unroll
        for (int ai = 0; ai < 2; ++ai) {
            if (u.pm * 256 + ai * 128 >= MROWS) continue;
#pragma unroll
            for (int m = 0; m < 4; ++m) {
                const int row = row0 + ai * 128 + m * 16;
                const float* xr = row < SEQ ? xp + (size_t)row * DM : xs + (size_t)(row - SEQ) * DM;
                float* orow = out + (size_t)row * DM;
                float ss = 0.f;
#pragma unroll
                for (int bj = 0; bj < 2; ++bj)
#pragma unroll
                    for (int n = 0; n < 2; ++n) {
                        const int col = col0 + bj * 128 + n * 16;
                        const f32x4 r = *(const f32x4*)(xr + col) + acc[ai][bj][m][n];
                        *(f32x4*)(orow + col) = r;
                        ss += (r[0] * r[0] + r[1] * r[1]) + (r[2] * r[2] + r[3] * r[3]);
                    }
                ss += __shfl_xor(ss, 16); ss += __shfl_xor(ss, 32);
                if (fq == 0) ssq[(size_t)row * 32 + u.pn * 4 + wc] = ss;
            }
        }
    }
};

typedef short v4i16_t __attribute__((ext_vector_type(4)));
__device__ __forceinline__ s16x4 ldtr(LAS const unsigned char* p) { return __builtin_bit_cast(s16x4, __builtin_amdgcn_ds_read_tr16_b64_v4i16((LAS v4i16_t*)p)); }
#define MFMA16(a, b, c) __builtin_amdgcn_mfma_f32_16x16x32_bf16((a), (b), (c), 0, 0, 0)

struct P2Ptrs { const bf16 *Q, *K, *V, *GA, *U, *GV, *GB, *WMP; const float* stats; bf16* AC; const float *ck, *cv, *ksn, *vsn, *qs, *ln_g, *ln_b, *w_s, *b_s; float* vc_out; };

#define ATT_WAITV(n) asm volatile("s_waitcnt vmcnt(" #n ")" ::: "memory")
__device__ __forceinline__ void glds16(const GAS unsigned char* gsrc, unsigned lds_dst) { unsigned keep;
    asm volatile("s_mov_b32 %0, m0\n\ts_mov_b32 m0, %2\n\ts_nop 0\n\tglobal_load_lds_dwordx4 %1, off\n\ts_mov_b32 m0, %0" : "=&s"(keep) : "v"(gsrc), "s"(lds_dst) : "memory"); }
__device__ __forceinline__ void attn_item(const Frame& F, const P2Ptrs& T, int h, int P0) {
    const int lane = F.lane, w = F.wave, q16 = lane & 15, g = lane >> 4;
    LAS float* ACC = (LAS float*)(F.lds + L_ACC);
    LAS float* ML = (LAS float*)(F.lds + L_ML);
    LAS unsigned char* VB = F.lds + L_VB + w * 8192;
    const unsigned vbase = (unsigned)(uintptr_t)VB;
    const GAS unsigned char* Qh = (const GAS unsigned char*)(T.Q + h * HDIM);
    const GAS unsigned char* Kh = (const GAS unsigned char*)(T.K + (size_t)PADR * DA + h * HDIM);
    const GAS unsigned char* Vh = (const GAS unsigned char*)(T.V + (size_t)PADR * DA + h * HDIM);
    const int jr = lane >> 3, jc = (lane & 7) ^ (((lane >> 4) & 3) << 1);
    const int qq = q16 >> 2, pp = q16 & 3, fh = 2 * (g & 1) + (qq >> 1);
    int tro[4];
#pragma unroll
    for (int n = 0; n < 4; ++n) tro[n] = (4 * g + qq) * 128 + (2 * (n ^ fh) + (pp >> 1)) * 16 + 8 * (pp & 1);
    bf16x8 kf[18], qf0, qf1;
#define ATT_GEOM(idx_, d_, qrel0_) const int d_ = (idx_) < 2 ? 1 : ((idx_) < 4 ? 4 : 16); const int tau_##d_ = 2 * w + ((idx_) & 1); \
        const int qrel0_ = (idx_) < 2 ? 16 * tau_##d_ : ((idx_) < 4 ? (tau_##d_ & 3) + 64 * (tau_##d_ >> 2) : tau_##d_);
#define ATT_LOADKQ(d_, pb_) do { const unsigned vo_ = (unsigned)((d_) * q16) * (DA * 2) + 16 * g; \
        const GAS unsigned char* qb_ = Qh + (size_t)(pb_) * (DA * 2); qf0 = *(const GAS bf16x8*)(qb_ + vo_); qf1 = *(const GAS bf16x8*)(qb_ + vo_ + 64); \
        _Pragma("unroll") for (int kt = 1; kt < 10; ++kt) { const GAS unsigned char* kb_ = Kh + (long)((pb_) + (d_) * (16 * kt - 144)) * (DA * 2); \
            kf[2 * kt - 2] = *(const GAS bf16x8*)(kb_ + vo_); kf[2 * kt - 1] = *(const GAS bf16x8*)(kb_ + vo_ + 64); } } while (0)
#define ATT_DMAV(d_, pb_, s_, buf_) do { const unsigned vo_ = (unsigned)((d_) * jr) * (DA * 2) + 16 * jc; \
        _Pragma("unroll") for (int i = 0; i < 4; ++i) { const GAS unsigned char* vb_ = Vh + (long)((pb_) + (d_) * (32 * (s_) + 8 * i - 144)) * (DA * 2); \
            glds16((const GAS unsigned char*)(vb_ + vo_), (unsigned)__builtin_amdgcn_readfirstlane((int)(vbase + (buf_) * 4096 + i * 1024))); } } while (0)
    { ATT_GEOM(0, d0, qr0); ATT_DMAV(d0, P0 + qr0, 0, 0); ATT_DMAV(d0, P0 + qr0, 1, 1); ATT_LOADKQ(d0, P0 + qr0); }
#pragma unroll 1
    for (int idx = 0; idx < 6; ++idx) {
        ATT_GEOM(idx, d, qrel0);
        const int pb = P0 + qrel0;
        f32x4 st[10];
#pragma unroll
        for (int kt = 1; kt < 10; ++kt) {
            const f32x4 a = MFMA16(kf[2 * kt - 2], qf0, ((f32x4){0.f, 0.f, 0.f, 0.f}));
            st[kt] = MFMA16(kf[2 * kt - 1], qf1, a);
        }
        const float NEG = -INFINITY;
#pragma unroll
        for (int r = 0; r < 4; ++r) { const int rk = 4 * g + r; if (rk < q16) st[1][r] = NEG; if (rk > q16) st[9][r] = NEG; }
        if (pb < 128 * d) {
#pragma unroll
            for (int kt = 1; kt < 10; ++kt)
#pragma unroll
                for (int r = 0; r < 4; ++r) if (pb + d * (16 * kt + 4 * g + r - 144) < 0) st[kt][r] = NEG;
        }
        float mx = NEG;
#pragma unroll
        for (int kt = 1; kt < 10; ++kt) mx = fmaxf(fmaxf(fmaxf(st[kt][0], st[kt][1]), fmaxf(st[kt][2], st[kt][3])), mx);
        mx = fmaxf(mx, __shfl_xor(mx, 16)); mx = fmaxf(mx, __shfl_xor(mx, 32));
        float ls = 0.f;
#pragma unroll
        for (int kt = 1; kt < 10; ++kt)
#pragma unroll
            for (int r = 0; r < 4; ++r) { const float e = __builtin_amdgcn_exp2f(st[kt][r] - mx); st[kt][r] = e; ls += e; }
        ls += __shfl_xor(ls, 16); ls += __shfl_xor(ls, 32);
        v4u pw[5];
        pw[0].x = 0u; pw[0].y = 0u; pw[0].z = cvtpk(st[1][0], st[1][1]); pw[0].w = cvtpk(st[1][2], st[1][3]);
#pragma unroll
        for (int s = 1; s < 5; ++s) { pw[s].x = cvtpk(st[2 * s][0], st[2 * s][1]); pw[s].y = cvtpk(st[2 * s][2], st[2 * s][3]); pw[s].z = cvtpk(st[2 * s + 1][0], st[2 * s + 1][1]); pw[s].w = cvtpk(st[2 * s + 1][2], st[2 * s + 1][3]); }
        __builtin_amdgcn_sched_barrier(0);
        ATT_WAITV(0);
        ATT_GEOM(idx + 1, dn, qrn);
        const int pbn = P0 + qrn;
        if (idx < 5) { ATT_LOADKQ(dn, pbn); }
        __builtin_amdgcn_sched_barrier(0);
        f32x4 o[4];
#pragma unroll
        for (int n = 0; n < 4; ++n) o[n] = (f32x4){0.f, 0.f, 0.f, 0.f};
#pragma unroll
        for (int s = 0; s < 5; ++s) {
            if (s == 2 || s == 3) ATT_WAITV(4); else if (s == 4) { if (idx < 5) ATT_WAITV(4); else ATT_WAITV(0); }
            const bf16x8 pf = __builtin_bit_cast(bf16x8, pw[s]);
            LAS unsigned char* vb = VB + (s & 1) * 4096;
            s16x4 lo[4], hi[4];
#pragma unroll
            for (int n = 0; n < 4; ++n) { lo[n] = ldtr(vb + tro[n]); hi[n] = ldtr(vb + tro[n] + 2048); }
            __builtin_amdgcn_sched_barrier(0);
#pragma unroll
            for (int n = 0; n < 4; ++n) {
                const bf16x8 vf = (bf16x8){lo[n][0], lo[n][1], lo[n][2], lo[n][3], hi[n][0], hi[n][1], hi[n][2], hi[n][3]};
                o[n] = MFMA16(pf, vf, o[n]);
            }
            asm volatile("s_waitcnt lgkmcnt(0)" ::: "memory");
            if (s < 3) { ATT_DMAV(d, pb, s + 2, s & 1); }
            else if (idx < 5) { ATT_DMAV(dn, pbn, 4 - s, s & 1); }
            __builtin_amdgcn_sched_barrier(0);
        }
        const int p = idx >> 1;
#pragma unroll
        for (int r = 0; r < 4; ++r) {
            const int rho = 4 * g + r;
            const float mp = __shfl(mx, rho), lp = __shfl(ls, rho);
            const int qrel = qrel0 + d * rho;
            LAS float* arow = ACC + qrel * ACC_STRIDE + q16;
            if (p == 0) {
#pragma unroll
                for (int n = 0; n < 4; ++n) arow[16 * n] = o[n][r];
                if (q16 == 0) { ML[2 * qrel] = mp; ML[2 * qrel + 1] = lp; }
            } else {
                const float mo = ML[2 * qrel], lo_ = ML[2 * qrel + 1];
                const float mn = fmaxf(mo, mp), ao = __builtin_amdgcn_exp2f(mo - mn), ap = __builtin_amdgcn_exp2f(mp - mn), ln = lo_ * ao + lp * ap;
                if (p == 1) {
#pragma unroll
                    for (int n = 0; n < 4; ++n) arow[16 * n] = arow[16 * n] * ao + o[n][r] * ap;
                    if (q16 == 0) { ML[2 * qrel] = mn; ML[2 * qrel + 1] = ln; }
                } else {
                    const float inv = 1.0f / ln;
#pragma unroll
                    for (int n = 0; n < 4; ++n) arow[16 * n] = (arow[16 * n] * ao + o[n][r] * ap) * inv;
                }
            }
        }
        if (idx & 1) asm volatile("s_waitcnt lgkmcnt(0)\n\ts_barrier" ::: "memory");
    }
#undef ATT_GEOM
#undef ATT_LOADKQ
#undef ATT_DMAV
#pragma unroll
    for (int i = 0; i < 4; ++i) {
        const int idx = F.tid + 512 * i, qrel = idx >> 3, c8 = idx & 7;
        const LAS float* ar = ACC + qrel * ACC_STRIDE + 8 * c8;
        const f32x4 a0 = *(const LAS f32x4*)ar, a1 = *(const LAS f32x4*)(ar + 4);
        const v4u gw = *(const v4u*)(T.GA + (size_t)(P0 + qrel) * DA + h * HDIM + 8 * c8);
        v4u o; o.x = cvtpk(a0[0] * bflo(gw.x), a0[1] * bfhi(gw.x)); o.y = cvtpk(a0[2] * bflo(gw.y), a0[3] * bfhi(gw.y));
        o.z = cvtpk(a1[0] * bflo(gw.z), a1[1] * bfhi(gw.z)); o.w = cvtpk(a1[2] * bflo(gw.w), a1[3] * bfhi(gw.w));
        *(v4u*)(T.AC + (size_t)(P0 + qrel) * DM + h * HDIM + 8 * c8) = o;
    }
    __syncthreads();
}

__device__ __forceinline__ void gmlp_item(const Frame& F, const P2Ptrs& T, int ck, int gi) {
    const int lane = F.lane, w = F.wave, q16 = lane & 15, g = lane >> 4, tid = F.tid;
    LAS unsigned char* IMG = F.lds;
    LAS f32x2v* RS = (LAS f32x2v*)(F.lds + 32768);
    const int r0 = ck * 128, ch0 = gi * 128;
    if (tid < 128) {
        const float* sp = T.stats + (size_t)(r0 + tid) * 32; float s1 = 0.f, s2 = 0.f;
#pragma unroll
        for (int i = 0; i < 8; ++i) { const f32x4 v = *(const f32x4*)(sp + 4 * i); s1 += v[0] + v[2]; s2 += v[1] + v[3]; }
        const float mu = s1 * (1.0f / DA), var = fmaxf(s2 * (1.0f / DA) - mu * mu, 0.f);
        f32x2v o; o.x = mu; o.y = 1.0f / sqrtf(var + EPS); RS[tid] = o;
    }
    __syncthreads();
#pragma unroll
    for (int i = 0; i < 4; ++i) {
        const int idx = tid + 512 * i, s = idx >> 4, c8 = idx & 15;
        const v4u gv = *(const v4u*)(T.GV + (size_t)(r0 + s) * DA + ch0 + 8 * c8);
        const f32x4 lg0 = *(const f32x4*)(T.ln_g + ch0 + 8 * c8), lg1 = *(const f32x4*)(T.ln_g + ch0 + 8 * c8 + 4);
        const f32x4 lb0 = *(const f32x4*)(T.ln_b + ch0 + 8 * c8), lb1 = *(const f32x4*)(T.ln_b + ch0 + 8 * c8 + 4);
        const f32x2v ms = RS[s];
        v4u o;
        o.x = cvtpk((bflo(gv.x) - ms.x) * ms.y * lg0[0] + lb0[0], (bfhi(gv.x) - ms.x) * ms.y * lg0[1] + lb0[1]);
        o.y = cvtpk((bflo(gv.y) - ms.x) * ms.y * lg0[2] + lb0[2], (bfhi(gv.y) - ms.x) * ms.y * lg0[3] + lb0[3]);
        o.z = cvtpk((bflo(gv.z) - ms.x) * ms.y * lg1[0] + lb1[0], (bfhi(gv.z) - ms.x) * ms.y * lg1[1] + lb1[1]);
        o.w = cvtpk((bflo(gv.w) - ms.x) * ms.y * lg1[2] + lb1[2], (bfhi(gv.w) - ms.x) * ms.y * lg1[3] + lb1[3]);
        *(LAS v4u*)(IMG + (c8 >> 1) * 4096 + s * 32 + (c8 & 1) * 16) = o;
    }
    __syncthreads();
    bf16x8 bfr[4];
    const int troff = w * 4096 + (4 * g + (q16 >> 2)) * 32 + (q16 & 3) * 8;
#pragma unroll
    for (int ss = 0; ss < 4; ++ss) {
        const s16x4 lo = ldtr(IMG + troff + ss * 1024), hi = ldtr(IMG + troff + ss * 1024 + 512);
        bfr[ss] = (bf16x8){lo[0], lo[1], lo[2], lo[3], hi[0], hi[1], hi[2], hi[3]};
    }
    const bf16* wm = T.WMP + (size_t)gi * 128 * 128;
    const int ch = ch0 + 16 * w + q16;
#pragma unroll
    for (int tt = 0; tt < 8; ++tt) {
        f32x4 acc = (f32x4){0.f, 0.f, 0.f, 0.f};
#pragma unroll
        for (int ss = 0; ss < 4; ++ss) {
            if (ss <= (tt >> 1)) {
                const bf16x8 af = *(const bf16x8*)(wm + (size_t)(16 * tt + q16) * 128 + 32 * ss + 8 * g);
                acc = MFMA16(af, bfr[ss], acc);
            }
        }
#pragma unroll
        for (int r = 0; r < 4; ++r) {
            const int t = 16 * tt + 4 * g + r; const size_t row = (size_t)(r0 + t);
            const float mixed = acc[r] + T.b_s[gi * 128 + t];
            const float uu = bf2f(T.U[row * DA + ch]), gb = bf2f(T.GB[row * DA + ch]);
            T.AC[row * DM + DA + ch] = (bf16)f2bf(uu * mixed * gb);
        }
    }
    __syncthreads();
}

__device__ __forceinline__ void sattn_item(const Frame& F, const P2Ptrs& T, int si) {
    const int lane = F.lane, w = F.wave, kk = lane >> 2, part = lane & 3;
    const int b = si >> 6, h = (si >> 2) & 15, t = si & 3;
    LAS float* SC = (LAS float*)(F.lds + w * 2048);
    const float* qp = T.qs + (size_t)(b * 4 + t) * DA + h * HDIM + 4 * part;
    f32x4 qv[4];
#pragma unroll
    for (int i = 0; i < 4; ++i) qv[i] = *(const f32x4*)(qp + 16 * i);
    float mx = -INFINITY;
#pragma unroll 1
    for (int p = 0; p < 3; ++p) {
        const int d = p == 0 ? 1 : (p == 1 ? 4 : 16);
#pragma unroll 3
        for (int ps = 0; ps < 9; ++ps) {
            const int j = ps * 16 + kk, jj = j > 128 ? 128 : j, idx = WBUF + t - jj * d;
            const float* kr = idx >= WBUF ? T.ksn + ((size_t)(b * 4 + idx - WBUF) * NHEAD + h) * HDIM : T.ck + ((size_t)(b * WBUF + idx) * NHEAD + h) * HDIM;
            kr += 4 * part;
            float s = 0.f;
#pragma unroll
            for (int i = 0; i < 4; ++i) { const f32x4 kv = *(const f32x4*)(kr + 16 * i); s += (qv[i][0] * kv[0] + qv[i][1] * kv[1]) + (qv[i][2] * kv[2] + qv[i][3] * kv[3]); }
            s += __shfl_xor(s, 1); s += __shfl_xor(s, 2);
            if (j > 128) s = -INFINITY;
            if (part == 0) SC[p * 144 + ps * 16 + kk] = s;
            mx = fmaxf(mx, s);
        }
    }
    mx = fmaxf(mx, __shfl_xor(mx, 4)); mx = fmaxf(mx, __shfl_xor(mx, 8)); mx = fmaxf(mx, __shfl_xor(mx, 16)); mx = fmaxf(mx, __shfl_xor(mx, 32));
    f32x4 o[4]; float ls = 0.f;
#pragma unroll
    for (int i = 0; i < 4; ++i) o[i] = (f32x4){0.f, 0.f, 0.f, 0.f};
#pragma unroll 1
    for (int p = 0; p < 3; ++p) {
        const int d = p == 0 ? 1 : (p == 1 ? 4 : 16);
#pragma unroll 3
        for (int ps = 0; ps < 9; ++ps) {
            const int j = ps * 16 + kk, jj = j > 128 ? 128 : j, idx = WBUF + t - jj * d;
            const float* vr = idx >= WBUF ? T.vsn + ((size_t)(b * 4 + idx - WBUF) * NHEAD + h) * HDIM : T.cv + ((size_t)(b * WBUF + idx) * NHEAD + h) * HDIM;
            vr += 4 * part;
            const float pe = __builtin_amdgcn_exp2f(SC[p * 144 + ps * 16 + kk] - mx);
            ls += pe;
#pragma unroll
            for (int i = 0; i < 4; ++i) { const f32x4 vv = *(const f32x4*)(vr + 16 * i); o[i] += vv * pe; }
        }
    }
#pragma unroll
    for (int sh = 4; sh < 64; sh <<= 1) {
        ls += __shfl_xor(ls, sh);
#pragma unroll
        for (int i = 0; i < 4; ++i)
#pragma unroll
            for (int e = 0; e < 4; ++e) o[i][e] += __shfl_xor(o[i][e], sh);
    }
    if (kk == 0) {
        const float inv = 1.0f / ls;
        const size_t row = (size_t)(SEQ + b * 4 + t);
#pragma unroll
        for (int i = 0; i < 4; ++i) {
            const int c = h * HDIM + 16 * i + 4 * part;
            const u32x2v gw = *(const u32x2v*)(T.GA + row * DA + c);
            u32x2v ov; ov.x = cvtpk(o[i][0] * inv * bflo(gw.x), o[i][1] * inv * bfhi(gw.x)); ov.y = cvtpk(o[i][2] * inv * bflo(gw.y), o[i][3] * inv * bfhi(gw.y));
            *(u32x2v*)(T.AC + row * DM + c) = ov;
        }
    }
}

__device__ __forceinline__ void sgmlp_item(const Frame& F, const P2Ptrs& T, int b) {
    const int lane = F.lane;
    float mu[4], rs[4];
    {
        const f32x2v pr = *(const f32x2v*)(T.stats + ((size_t)(SEQ + b * 4 + (lane >> 4)) * 16 + (lane & 15)) * 2);
        float s1 = pr.x, s2 = pr.y;
#pragma unroll
        for (int o = 1; o < 16; o <<= 1) { s1 += __shfl_xor(s1, o); s2 += __shfl_xor(s2, o); }
        const float m_ = s1 * (1.0f / DA), var = fmaxf(s2 * (1.0f / DA) - m_ * m_, 0.f), r_ = 1.0f / sqrtf(var + EPS);
#pragma unroll
        for (int t = 0; t < 4; ++t) { mu[t] = __shfl(m_, 16 * t); rs[t] = __shfl(r_, 16 * t); }
    }
#pragma unroll 1
    for (int hh = 0; hh < 2; ++hh) {
        const int ch = hh * 512 + lane * 8, gi = ch >> 7;
        float lg[8], lb[8];
#pragma unroll
        for (int e = 0; e < 8; ++e) { lg[e] = T.ln_g[ch + e]; lb[e] = T.ln_b[ch + e]; }
        float vn[4][8];
#pragma unroll
        for (int t = 0; t < 4; ++t) {
            const size_t row = (size_t)(SEQ + b * 4 + t);
            const v4u gv = *(const v4u*)(T.GV + row * DA + ch);
            const unsigned wv[4] = {gv.x, gv.y, gv.z, gv.w};
#pragma unroll
            for (int e = 0; e < 4; ++e) { vn[t][2 * e] = (bflo(wv[e]) - mu[t]) * rs[t] * lg[2 * e] + lb[2 * e]; vn[t][2 * e + 1] = (bfhi(wv[e]) - mu[t]) * rs[t] * lg[2 * e + 1] + lb[2 * e + 1]; }
            float* vo = T.vc_out + (size_t)(b * 4 + t) * DA + ch;
            *(f32x4*)vo = (f32x4){vn[t][0], vn[t][1], vn[t][2], vn[t][3]}; *(f32x4*)(vo + 4) = (f32x4){vn[t][4], vn[t][5], vn[t][6], vn[t][7]};
        }
#pragma unroll
        for (int t = 0; t < 4; ++t) {
            const size_t row = (size_t)(SEQ + b * 4 + t);
            float mix[8];
            const float bias = T.b_s[gi * 128 + t];
#pragma unroll
            for (int e = 0; e < 8; ++e) mix[e] = bias;
#pragma unroll
            for (int s = 0; s < 4; ++s) if (s <= t) { const float wts = T.w_s[(size_t)(gi * 128 + t) * 128 + s];
#pragma unroll
                for (int e = 0; e < 8; ++e) mix[e] += wts * vn[s][e]; }
            const v4u uv = *(const v4u*)(T.U + row * DA + ch), gb = *(const v4u*)(T.GB + row * DA + ch);
            v4u o;
            o.x = cvtpk(bflo(uv.x) * mix[0] * bflo(gb.x), bfhi(uv.x) * mix[1] * bfhi(gb.x)); o.y = cvtpk(bflo(uv.y) * mix[2] * bflo(gb.y), bfhi(uv.y) * mix[3] * bfhi(gb.y));
            o.z = cvtpk(bflo(uv.z) * mix[4] * bflo(gb.z), bfhi(uv.z) * mix[5] * bfhi(gb.z)); o.w = cvtpk(bflo(uv.w) * mix[6] * bflo(gb.w), bfhi(uv.w) * mix[7] * bfhi(gb.w));
            *(v4u*)(T.AC + row * DM + DA + ch) = o;
        }
    }
}


__device__ __forceinline__ void sout_item(const Frame& F, const bf16* AC, const bf16* WoT, const float* xs, float* out, float* ssq, int rt, int ct) {
    const int lane = F.lane, w = F.wave, q16 = lane & 15, g = lane >> 4, tid = F.tid;
    LAS float* RED = (LAS float*)F.lds;
    const GAS unsigned char* ab = (const GAS unsigned char*)(AC + (size_t)(SEQ + 16 * rt + q16) * DM + 256 * w + 8 * g);
    const GAS unsigned char* bb = (const GAS unsigned char*)(WoT + (size_t)(64 * ct + q16) * DM + 256 * w + 8 * g);
    bf16x8 af[8];
#pragma unroll
    for (int ks = 0; ks < 8; ++ks) af[ks] = *(const GAS bf16x8*)(ab + 64 * ks);
    f32x4 acc[4];
#pragma unroll
    for (int nb = 0; nb < 4; ++nb) {
        bf16x8 bf_[8];
#pragma unroll
        for (int ks = 0; ks < 8; ++ks) bf_[ks] = *(const GAS bf16x8*)(bb + (size_t)nb * 16 * DM * 2 + 64 * ks);
        f32x4 a = (f32x4){0.f, 0.f, 0.f, 0.f};
#pragma unroll
        for (int ks = 0; ks < 8; ++ks) a = MFMA16(af[ks], bf_[ks], a);
        acc[nb] = a;
    }
#pragma unroll
    for (int nb = 0; nb < 4; ++nb)
#pragma unroll
        for (int r = 0; r < 4; ++r) RED[(w * 16 + 4 * g + r) * 64 + 16 * nb + q16] = acc[nb][r];
    __syncthreads();
    {
        const int row = tid >> 5, c2 = (tid & 31) * 2;
        float s0 = 0.f, s1 = 0.f;
#pragma unroll
        for (int ww = 0; ww < 8; ++ww) { const f32x2v v = *(const LAS f32x2v*)(RED + (ww * 16 + row) * 64 + c2); s0 += v.x; s1 += v.y; }
        const size_t grow = (size_t)(SEQ + 16 * rt + row);
        const f32x2v xr = *(const f32x2v*)(xs + (size_t)(16 * rt + row) * DM + 64 * ct + c2);
        f32x2v y; y.x = xr.x + s0; y.y = xr.y + s1;
        *(f32x2v*)(out + grow * DM + 64 * ct + c2) = y;
        float ss = y.x * y.x + y.y * y.y;
#pragma unroll
        for (int o = 1; o < 32; o <<= 1) ss += __shfl_xor(ss, o);
        if ((tid & 31) == 0) ssq[grow * 32 + ct] = ss;
    }
    __syncthreads();
}

__device__ __forceinline__ void p2_mixers(const Frame& F, const P2Ptrs& T) {
    for (int it = F.vcu; it < 512 * REP_ATT; it += F.G) attn_item(F, T, (it & 511) >> 5, (it & 31) * 256);
    for (int it = F.vcu; it < 512; it += F.G) gmlp_item(F, T, it >> 3, it & 7);
#if REP_GMLP > 1
    for (int it = F.vcu; it < 512; it += F.G) gmlp_item(F, T, it >> 3, it & 7);
#endif
    const int gw = F.vcu * NWAVES + F.wave, NGW = F.G * NWAVES;
    for (int si = gw; si < 2048; si += NGW) sattn_item(F, T, si);
#if REP_SATT > 1
    for (int si = gw; si < 2048; si += NGW) sattn_item(F, T, si);
#endif
    for (int b = gw; b < 32; b += NGW) sgmlp_item(F, T, b);
}

__device__ __forceinline__ void p4_final(const Frame& F, float* out, const float* ssq, const float* fg) {
    const int gw = F.vcu * NWAVES + F.wave, NGW = F.G * NWAVES, lane = F.lane;
    f32x4 gv[8];
#pragma unroll
    for (int j = 0; j < 8; ++j) gv[j] = *((const f32x4*)fg + 64 * j + lane);
    for (int m = gw; m < MROWS; m += NGW) {
        float s = lane < 32 ? ssq[(size_t)m * 32 + lane] : 0.f;
        s = wave_sum(s);
        const float r = 1.0f / sqrtf(s * (1.0f / DM) + EPS);
        f32x4* yr = (f32x4*)(out + (size_t)m * DM) + lane;
#pragma unroll
        for (int j = 0; j < 8; ++j) { const f32x4 v = yr[64 * j]; yr[64 * j] = v * r * gv[j]; }
    }
}


__global__ void __launch_bounds__(NWAVES * 64, 2) hybrid_fwd(Args args) {
    extern __shared__ __attribute__((aligned(16))) unsigned char lds[];
    Frame F;
    F.lds = (LAS unsigned char*)lds;
    F.tid = threadIdx.x; F.lane = F.tid & 63; F.wave = __builtin_amdgcn_readfirstlane(F.tid >> 6);
    F.G = gridDim.x; { const int bx = blockIdx.x; F.vcu = (F.G % 8 == 0) ? (bx % 8) * (F.G / 8) + bx / 8 : bx; }
    unsigned char* ws = args.ws;
    volatile LAS unsigned* MISC = (volatile LAS unsigned*)(F.lds + MISC_OFF);
    if (F.tid < 64) MISC[F.tid] = 0u;
    __syncthreads();
    XcdBarrier bar = xcd_barrier_post((unsigned*)(ws + WS_CTL) + CW_BAR, MISC + 8);

#ifndef SKIP_P0
    p0_prologue(F, args);
#endif
#if REP_P0 > 1
    p0_prologue(F, args);
#endif
    xcd_barrier(bar);

#ifndef SKIP_P1
    for (int rep = 0; rep < REP_P1; ++rep) {
        pg8::Gemm g{(const pg8::bf16_t*)(ws + WS_XN), (const pg8::bf16_t*)(ws + WS_WIN), MP, DIN, DM};
        pg8::StaticOrder S; S.init(MP, DIN, F.G, (int)blockIdx.x);
        EpiIn E{(bf16*)(ws + WS_Q), (bf16*)(ws + WS_K) + (size_t)PADR * DA, (bf16*)(ws + WS_V) + (size_t)PADR * DA, (bf16*)(ws + WS_GA), (bf16*)(ws + WS_U), (bf16*)(ws + WS_GV), (bf16*)(ws + WS_GB),
                (const float*)(ws + WS_ROPE), (float*)(ws + WS_STATS), args.out, (float*)(ws + WS_QS)};
        pg8::gemm_phase<EpiIn, pg8::StaticOrder, true, true>(F.lds, g, S, E);
    }
    xcd_barrier(bar);

#endif
#ifndef SKIP_P2
    {
        P2Ptrs T{(const bf16*)(ws + WS_Q), (const bf16*)(ws + WS_K), (const bf16*)(ws + WS_V), (const bf16*)(ws + WS_GA), (const bf16*)(ws + WS_U), (const bf16*)(ws + WS_GV), (const bf16*)(ws + WS_GB),
                 (const bf16*)(ws + WS_WMP), (const float*)(ws + WS_STATS), (bf16*)(ws + WS_AC), args.in[2], args.in[3], args.out + OFF_KS, args.out + OFF_VS, (const float*)(ws + WS_QS),
                 args.in[6], args.in[7], args.in[8], args.in[9], args.out + OFF_VC};
        p2_mixers(F, T);
    }
    xcd_barrier(bar);

#endif
#ifndef SKIP_P3
    for (int it = F.vcu; it < 256; it += F.G) sout_item(F, (const bf16*)(ws + WS_AC), (const bf16*)(ws + WS_WOUT), args.in[1], args.out, (float*)(ws + WS_SS), it >> 5, it & 31);
    for (int rep = 0; rep < REP_P3; ++rep) {
        pg8::Gemm g{(const pg8::bf16_t*)(ws + WS_AC), (const pg8::bf16_t*)(ws + WS_WOUT), SEQ, DM, DM};
        pg8::StaticOrder S; S.init(SEQ, DM, F.G, (int)blockIdx.x);
        EpiOut E{args.in[0], args.in[1], args.out, (float*)(ws + WS_SS)};
        pg8::gemm_phase<EpiOut, pg8::StaticOrder, true, true>(F.lds, g, S, E);
    }
    xcd_barrier(bar);

#endif
    p4_final(F, args.out, (const float*)(ws + WS_SS), args.in[11]);
}

extern "C" void kernel_launch(void* const* d_in, const int* in_sizes, int n_in, void* d_out, int out_size, void* d_ws, size_t ws_size, hipStream_t stream) {
    static int grid = 0;
    if (grid == 0) {
        if (n_in != 12 || out_size != (int)OUT_TOTAL || ws_size < WS_END) { fprintf(stderr, "kernel_launch: unexpected shapes (n_in %d out %d ws %zu)\n", n_in, out_size, ws_size); grid = -1; return; }
        int dev = 0, cus = 0, per_cu = 0;
        if (hipGetDevice(&dev) != hipSuccess || hipDeviceGetAttribute(&cus, hipDeviceAttributeMultiprocessorCount, dev) != hipSuccess) { grid = -1; return; }
        if (hipFuncSetAttribute((const void*)hybrid_fwd, hipFuncAttributeMaxDynamicSharedMemorySize, LDS_BYTES) != hipSuccess) { fprintf(stderr, "kernel_launch: hipFuncSetAttribute failed\n"); grid = -1; return; }
        if (hipOccupancyMaxActiveBlocksPerMultiprocessor(&per_cu, (const void*)hybrid_fwd, NWAVES * 64, LDS_BYTES) != hipSuccess || per_cu < 1) { fprintf(stderr, "kernel_launch: occupancy query reports %d blocks per CU\n", per_cu); (void)hipGetLastError(); grid = -1; return; }
        grid = cus;
    }
    if (grid < 0) return;
    if (hipMemsetAsync((char*)d_ws + WS_CTL, 0, CTL_ZERO_BYTES, stream) != hipSuccess) return;
    Args a{};
    for (int i = 0; i < 12; ++i) a.in[i] = (const float*)d_in[i];
    a.out = (float*)d_out; a.ws = (unsigned char*)d_ws;
    for (int i = 0; i < 32; ++i) a.invf[i] = exp(-log(10000.0) * (double)i / 32.0);
    hipLaunchKernelGGL(hybrid_fwd, dim3(grid), dim3(NWAVES * 64), LDS_BYTES, stream, a);
}
```

```cpp
#include <hip/hip_runtime.h>
#include <cstdio>
#include <cstdint>
#include <cmath>

namespace pg8 {
#define PG8_LAS __attribute__((address_space(3)))
typedef unsigned short bf16_t;
typedef short bf16x8 __attribute__((ext_vector_type(8)));
typedef float f32x4 __attribute__((ext_vector_type(4)));
typedef unsigned u32x4 __attribute__((ext_vector_type(4)));
constexpr int BM = 256, BK = 64, HALF = 128, HTB = HALF * BK * 2  , STAGE_BYTES = 8 * HTB, NXCD = 8, WGM = 8;

__host__ __device__ __forceinline__ int lds_byte(int r, int c) { const int st = (r >> 4) * 2 + (c >> 5), rr = r & 15, cc = c & 31, ob = rr * 64 + cc * 2; return st * 1024 + (ob ^ (((ob >> 9) & 1) << 5)); }
__host__ __device__ __forceinline__ void stage_rc(int b, int& R, int& C) { const int st = b / 1024, sb = b % 1024, swz = sb ^ (((sb >> 9) & 1) << 5); R = (st >> 1) * 16 + swz / 64; C = (st & 1) * 32 + (swz % 64) / 2; }
__host__ __device__ __forceinline__ int perm32(int rho) { const int n = rho >> 4, i = rho & 15; return 8 * (i >> 2) + 4 * n + (i & 3); }

struct Unit { int pm, pn; };
struct Gemm { const bf16_t* A; const bf16_t* Bt; int M, N, K; };

struct StaticOrder {
    int nM, nN, nwg, G, c;
    __host__ __device__ void init(int M, int N, int G_, int c_) { nM = M / BM; nN = N / BM; nwg = nM * nN; G = G_; c = c_; }
    __host__ __device__ bool next(int i, Unit& u) const {
        const long L = (long)i * G + c; if (L >= nwg) return false;
        int wgid = (int)L; { const int q = nwg / NXCD, r = nwg % NXCD, xcd = wgid % NXCD, off = wgid / NXCD; wgid = (xcd < r ? xcd * (q + 1) : r * (q + 1) + (xcd - r) * q) + off; }
        const int nig = WGM * nN, gid = wgid / nig, fm = gid * WGM, gsz = (nM - fm) < WGM ? (nM - fm) : WGM;
        u.pm = fm + ((wgid % nig) % gsz); u.pn = (wgid % nig) / gsz; return true;
    }
    __device__ __forceinline__ void a_ready(const Unit&) const {}
    __device__ __forceinline__ void done(const Unit&) const {}
};
__device__ __forceinline__ unsigned cvt_pk_bf16(float lo, float hi) { unsigned r; asm volatile("v_cvt_pk_bf16_f32 %0, %1, %2" : "=v"(r) : "v"(lo), "v"(hi)); return r; }
template <class Epi, class Sched, bool ALIGN_EPI = false, bool SP2 = false>
__device__ __forceinline__ void gemm_phase(PG8_LAS unsigned char* lds, const Gemm g, const Sched& S, const Epi& E) {
    const int tid = threadIdx.x, wid = __builtin_amdgcn_readfirstlane(tid >> 6), lane = tid & 63, wr = wid >> 2, wc = wid & 3, fr = lane & 15, fq = lane >> 4;
    const int K = g.K, nt = K / BK;
    unsigned voffA[2], voffB[2];
#pragma unroll
    for (int i = 0; i < 2; ++i) { int R, C; stage_rc(tid * 16 + i * 8192, R, C); const int Rb = Epi::PERM ? ((R & ~31) + perm32(R & 31)) : R;
        voffA[i] = (unsigned)(R * K + C) * 2u; voffB[i] = (unsigned)(Rb * K + C) * 2u; }
    const size_t kstep = (size_t)(BK * 2);
    const size_t hstep = (size_t)HALF * K * 2;
    const size_t tstep = 2 * hstep;
    const unsigned ldsw = (unsigned)wid * 1024u;
    const int aoff = lds_byte(wr * 64 + fr, fq * 8), boff = lds_byte(wc * 32 + fr, fq * 8);
#define PG8_SA(b, h) (((b) * 2 + (h)) * HTB)
#define PG8_SB(b, h) ((4 + (b) * 2 + (h)) * HTB)
#define PG8_STAGE(bufoff, gbase, voff) do { _Pragma("unroll") for (int _i = 0; _i < 2; ++_i) \
        __builtin_amdgcn_global_load_lds((const unsigned*)((const char*)(gbase) + (voff)[_i]), (PG8_LAS unsigned*)(lds + (bufoff) + ldsw + _i * 8192), 16, 0, 0); } while (0)
#define PG8_LDA(dst, b, h) do { _Pragma("unroll") for (int m = 0; m < 4; ++m) _Pragma("unroll") for (int k = 0; k < 2; ++k) dst[m][k] = *(const PG8_LAS bf16x8*)(lds + PG8_SA(b, h) + aoff + m * 2048 + k * 1024); } while (0)
#define PG8_LDB(dst, b, h) do { _Pragma("unroll") for (int n = 0; n < 2; ++n) _Pragma("unroll") for (int k = 0; k < 2; ++k) dst[n][k] = *(const PG8_LAS bf16x8*)(lds + PG8_SB(b, h) + boff + n * 2048 + k * 1024); } while (0)
#define PG8_MMA(ai, bj, At, Bt) do { __builtin_amdgcn_s_setprio(1); _Pragma("unroll") for (int m = 0; m < 4; ++m) _Pragma("unroll") for (int n = 0; n < 2; ++n) _Pragma("unroll") for (int k = 0; k < 2; ++k) \
        acc[ai][bj][m][n] = __builtin_amdgcn_mfma_f32_16x16x32_bf16(Bt[n][k], At[m][k], acc[ai][bj][m][n], 0, 0, 0); __builtin_amdgcn_s_setprio(0); } while (0)
#define PG8_WAIT_V(n) asm volatile("s_waitcnt vmcnt(" #n ")" ::: "memory")
#define PG8_WAIT_L(n) asm volatile("s_waitcnt lgkmcnt(" #n ")" ::: "memory")
#define PG8_BAR __builtin_amdgcn_s_barrier()
#define PG8_SCHED __builtin_amdgcn_sched_barrier(0)
    Unit cur, nxt; int ui = 0;
    if (!S.next(0, cur)) return;
    f32x4 acc[2][2][4][2];
#pragma unroll
    for (int a = 0; a < 2; ++a)
#pragma unroll
        for (int b = 0; b < 2; ++b)
#pragma unroll
            for (int m = 0; m < 4; ++m)
#pragma unroll
                for (int n = 0; n < 2; ++n) acc[a][b][m][n] = (f32x4){0.f, 0.f, 0.f, 0.f};
    bf16x8 At[4][2], B0[2][2], B1[2][2];
    const char* cA = (const char*)g.A + (size_t)cur.pm * tstep; const char* cB = (const char*)g.Bt + (size_t)cur.pn * tstep;
    S.a_ready(cur);
    if constexpr (SP2) {
        PG8_STAGE(PG8_SB(0, 0), cB, voffB); PG8_STAGE(PG8_SB(0, 1), cB + hstep, voffB); PG8_STAGE(PG8_SA(0, 0), cA, voffA); PG8_STAGE(PG8_SA(0, 1), cA + hstep, voffA);
        if (wr == 1) PG8_BAR;
        PG8_WAIT_V(2); PG8_BAR;
        PG8_STAGE(PG8_SB(1, 0), cB + kstep, voffB); PG8_STAGE(PG8_SA(1, 0), cA + kstep, voffA); PG8_STAGE(PG8_SB(1, 1), cB + hstep + kstep, voffB);
        PG8_WAIT_V(6); PG8_BAR;
    } else {
        PG8_STAGE(PG8_SB(0, 0), cB, voffB); PG8_STAGE(PG8_SA(0, 0), cA, voffA); PG8_STAGE(PG8_SB(0, 1), cB + hstep, voffB); PG8_STAGE(PG8_SA(0, 1), cA + hstep, voffA);
        if (wr == 1) PG8_BAR;
        PG8_WAIT_V(4); PG8_BAR;
        PG8_STAGE(PG8_SB(1, 0), cB + kstep, voffB); PG8_STAGE(PG8_SA(1, 0), cA + kstep, voffA); PG8_STAGE(PG8_SB(1, 1), cB + hstep + kstep, voffB);
        PG8_WAIT_V(6); PG8_BAR;
    }
    for (;;) {
        const bool has_next = S.next(ui + 1, nxt);
        const char* nA = has_next ? (const char*)g.A + (size_t)nxt.pm * tstep : cA; const char* nB = has_next ? (const char*)g.Bt + (size_t)nxt.pn * tstep : cB;
        for (int t = 0; t < nt; t += 2) {
            const bool last = (t == nt - 2);
            const char* a1 = cA + (size_t)(t + 1) * kstep;
            const char* a2 = last ? nA : cA + (size_t)(t + 2) * kstep; const char* b2 = last ? nB : cB + (size_t)(t + 2) * kstep;
            const char* a3 = a2 + kstep; const char* b3 = b2 + kstep;
            if (last && has_next) S.a_ready(nxt);
            if constexpr (SP2) {
            PG8_LDB(B0, 0, 0); PG8_LDB(B1, 0, 1); PG8_SCHED; PG8_LDA(At, 0, 0); PG8_STAGE(PG8_SA(1, 1), a1 + hstep, voffA);
            PG8_WAIT_V(8); PG8_WAIT_L(0); PG8_BAR; PG8_MMA(0, 0, At, B0); PG8_MMA(0, 1, At, B1); PG8_BAR; PG8_SCHED;
            PG8_LDA(At, 0, 1); PG8_STAGE(PG8_SB(0, 0), b2, voffB); PG8_STAGE(PG8_SB(0, 1), b2 + hstep, voffB); PG8_STAGE(PG8_SA(0, 0), a2, voffA);
            PG8_WAIT_V(8); PG8_WAIT_L(0); PG8_BAR; PG8_MMA(1, 0, At, B0); PG8_MMA(1, 1, At, B1); PG8_BAR; PG8_SCHED;
            PG8_LDB(B0, 1, 0); PG8_LDB(B1, 1, 1); PG8_SCHED; PG8_LDA(At, 1, 0); PG8_STAGE(PG8_SA(0, 1), a2 + hstep, voffA);
            PG8_WAIT_V(8); PG8_WAIT_L(0); PG8_BAR; PG8_MMA(0, 0, At, B0); PG8_MMA(0, 1, At, B1); PG8_BAR; PG8_SCHED;
            PG8_LDA(At, 1, 1); PG8_STAGE(PG8_SB(1, 0), b3, voffB); PG8_STAGE(PG8_SB(1, 1), b3 + hstep, voffB); PG8_STAGE(PG8_SA(1, 0), a3, voffA);
            PG8_WAIT_V(8); PG8_WAIT_L(0); PG8_BAR; PG8_MMA(1, 0, At, B0); PG8_MMA(1, 1, At, B1); PG8_BAR; PG8_SCHED;
            } else {
            PG8_LDB(B0, 0, 0); PG8_SCHED; PG8_LDA(At, 0, 0); PG8_STAGE(PG8_SA(1, 1), a1 + hstep, voffA);
            PG8_WAIT_L(8); PG8_BAR; PG8_WAIT_L(0); PG8_MMA(0, 0, At, B0); PG8_BAR; PG8_SCHED;
            PG8_LDB(B1, 0, 1); PG8_STAGE(PG8_SB(0, 0), b2, voffB);
            PG8_BAR; PG8_WAIT_L(0); PG8_MMA(0, 1, At, B1); PG8_BAR;
            PG8_LDA(At, 0, 1); PG8_STAGE(PG8_SA(0, 0), a2, voffA);
            PG8_BAR; PG8_WAIT_L(0); PG8_MMA(1, 0, At, B0); PG8_BAR; PG8_SCHED;
            PG8_STAGE(PG8_SB(0, 1), b2 + hstep, voffB);
            PG8_WAIT_V(6); PG8_BAR; PG8_MMA(1, 1, At, B1); PG8_BAR;
            PG8_LDB(B0, 1, 0); PG8_SCHED; PG8_LDA(At, 1, 0); PG8_STAGE(PG8_SA(0, 1), a2 + hstep, voffA);
            PG8_WAIT_L(8); PG8_BAR; PG8_WAIT_L(0); PG8_MMA(0, 0, At, B0); PG8_BAR; PG8_SCHED;
            PG8_LDB(B1, 1, 1); PG8_STAGE(PG8_SB(1, 0), b3, voffB);
            PG8_BAR; PG8_WAIT_L(0); PG8_MMA(0, 1, At, B1); PG8_BAR;
            PG8_LDA(At, 1, 1); PG8_STAGE(PG8_SA(1, 0), a3, voffA);
            PG8_BAR; PG8_WAIT_L(0); PG8_MMA(1, 0, At, B0); PG8_BAR; PG8_SCHED;
            PG8_STAGE(PG8_SB(1, 1), b3 + hstep, voffB);
            PG8_WAIT_V(6); PG8_BAR; PG8_MMA(1, 1, At, B1); PG8_BAR;
            }
        }
        if constexpr (ALIGN_EPI) { if (wr == 0) PG8_BAR; }
        if constexpr (!Epi::AFTER_DRAIN) { E(acc, cur, wr, wc, fr, fq); S.done(cur); }
        if (!has_next) break;
#pragma unroll
        for (int a = 0; a < 2; ++a)
#pragma unroll
            for (int b = 0; b < 2; ++b)
#pragma unroll
                for (int m = 0; m < 4; ++m)
#pragma unroll
                    for (int n = 0; n < 2; ++n) acc[a][b][m][n] = (f32x4){0.f, 0.f, 0.f, 0.f};
        cur = nxt; cA = nA; cB = nB; ++ui;
        if constexpr (ALIGN_EPI) { if (wr == 1) PG8_BAR; }
    }
    PG8_WAIT_V(0);
    if constexpr (!ALIGN_EPI) { if (wr == 0) PG8_BAR; }
    PG8_BAR;
    if constexpr (Epi::AFTER_DRAIN) { E.fused(acc, cur, wr, wc, fr, fq, lds, wid, lane); S.done(cur); }
#undef PG8_SA
#undef PG8_SB
#undef PG8_STAGE
#undef PG8_LDA
#undef PG8_LDB
#undef PG8_MMA
#undef PG8_WAIT_V
#undef PG8_WAIT_L
#undef PG8_BAR
#undef PG8_SCHED
}
}

#ifndef REP_P0
#define REP_P0 1
#endif
#ifndef REP_P1
#define REP_P1 1
#endif
#ifndef REP_ATT
#define REP_ATT 1
#endif
#ifndef REP_GMLP
#define REP_GMLP 1
#endif
#ifndef REP_SATT
#define REP_SATT 1
#endif
#ifndef REP_P3
#define REP_P3 1
#endif
#ifndef REP_BAR
#define REP_BAR 1
#endif
#ifndef REP_P4
#define REP_P4 1
#endif

constexpr int NWAVES = 8;
constexpr int DM = 2048, SEQ = 8192, NSAMP = 128, MROWS = SEQ + NSAMP  , MP = 8448  , DIN = 7168, DA = 1024, NHEAD = 16, HDIM = 64;
constexpr int WBUF = 2048, TAIL0 = SEQ - 2048, PAST = 16384, NSLOT = SEQ + 4;
constexpr float EPS = 1e-6f;
constexpr float QSCALE = 0.125f * 1.4426950408889634f;
constexpr size_t OFF_YP = 0, OFF_YS = 16777216, OFF_KT = 17039360, OFF_VT = 19136512, OFF_KS = 21233664, OFF_VS = 21364736, OFF_VC = 21495808, OUT_TOTAL = 21626880;

constexpr size_t MiB = 1u << 20;
constexpr size_t WS_CTL = 0, CTL_ZERO_BYTES = 1 * MiB;
constexpr size_t WS_WIN = 2 * MiB, WS_WOUT = 30 * MiB, WS_XN = 38 * MiB, WS_ROPE = 71 * MiB;
constexpr int PADR = 2304;
constexpr size_t WS_Q = 74 * MiB, WS_K = 91 * MiB, WS_V = 112 * MiB, WS_GA = 133 * MiB, WS_U = 150 * MiB, WS_GV = 167 * MiB, WS_GB = 184 * MiB;
constexpr size_t WS_STATS = 201 * MiB, WS_AC = 203 * MiB, WS_SS = 236 * MiB, WS_WMP = 238 * MiB, WS_QS = 239 * MiB, WS_Y = 240 * MiB, WS_END = 308 * MiB;
static_assert((size_t)(MP + PADR) * DA * 2 <= 21 * MiB, "K / V with padding rows");
constexpr int CW_BAR = 4096;

constexpr int LDS_BYTES = 147456;
constexpr int MISC_OFF = LDS_BYTES - 256;
constexpr int ACC_STRIDE = 68;
constexpr int L_ACC = 0, L_ML = 256 * ACC_STRIDE * 4  , L_VB = L_ML + 2048  , L_END_ATT = L_VB + NWAVES * 8192;
static_assert(L_END_ATT <= MISC_OFF, "LDS map");

#define GAS __attribute__((address_space(1)))
#define LAS __attribute__((address_space(3)))
typedef unsigned short bf16;
typedef unsigned v4u __attribute__((ext_vector_type(4)));
typedef float f32x4 __attribute__((ext_vector_type(4)));
typedef short bf16x8 __attribute__((ext_vector_type(8)));
typedef GAS unsigned gu32;
typedef GAS unsigned long long gu64;
#define RLX_AGENT __ATOMIC_RELAXED, __HIP_MEMORY_SCOPE_AGENT
#define LDS_WAIT() asm volatile("s_waitcnt lgkmcnt(0)" ::: "memory")
#define VM_WAIT() asm volatile("s_waitcnt vmcnt(0)" ::: "memory")
__device__ __forceinline__ unsigned long long rt() { return __builtin_amdgcn_s_memrealtime(); }
__device__ __forceinline__ unsigned f2bf(float f) { unsigned u = __builtin_bit_cast(unsigned, f); return (u + 0x7fffu + ((u >> 16) & 1u)) >> 16; }
__device__ __forceinline__ unsigned pk2(float lo, float hi) { return f2bf(lo) | (f2bf(hi) << 16); }
#define XB_TMO      128
#define XB_XCNT(j)  (256  + 64 * (j))
#define XB_XSUB(j)  (1280 + 64 * (j))
#define XB_XGEN(j)  (2304 + 64 * (j))
#define XB_TOP      3328
#define XB_TOPGEN   3392
#define XCD_BAR_WORDS 3456
#define XB_SPIN_CAP (1u << 18)

__device__ __forceinline__ unsigned xb_ld(unsigned* p)              { return __hip_atomic_load(p, __ATOMIC_RELAXED, __HIP_MEMORY_SCOPE_AGENT); }
__device__ __forceinline__ unsigned xb_add(unsigned* p, unsigned v) { return __hip_atomic_fetch_add(p, v, __ATOMIC_RELAXED, __HIP_MEMORY_SCOPE_AGENT); }
__device__ __forceinline__ unsigned xb_xcc_id() { return (unsigned)__builtin_amdgcn_s_getreg((3 << 11) | 20) & 0xFu; }
#define XB_SPIN(cond, bar) do { unsigned _sp = 0; while (cond) { __builtin_amdgcn_s_sleep(1); \
    if ((++_sp & 255u) == 0u) { if (xb_ld(&(bar)[XB_TMO])) break; if (_sp > XB_SPIN_CAP) { atomicAdd(&(bar)[XB_TMO], 1u); break; } } } } while (0)

struct XcdBarrier {
    unsigned* bar; unsigned x;
    volatile LAS unsigned* st;
};

__device__ __forceinline__ XcdBarrier xcd_barrier_post(unsigned* bar, volatile LAS unsigned* st) {
    XcdBarrier b; b.bar = bar; b.x = xb_xcc_id(); b.st = st;
    if (threadIdx.x == 0) (void)xb_add(&bar[XB_XCNT(b.x)], 1u);
    return b;
}
__device__ __forceinline__ void xcd_barrier_complete(unsigned* bar, unsigned x, unsigned& nloc, unsigned& nx) {
    const unsigned G = gridDim.x * gridDim.y * gridDim.z;
    unsigned sum, cnt, mine, sp = 0u;
    for (;;) {
        sum = 0u; cnt = 0u; mine = 0u;
#pragma unroll
        for (unsigned j = 0; j < 16; ++j) { const unsigned c = xb_ld(&bar[XB_XCNT(j)]); sum += c; cnt += (c > 0u) ? 1u : 0u; mine = (j == x) ? c : mine; }
        if (sum == G) break;
        __builtin_amdgcn_s_sleep(1);
        if ((++sp & 255u) == 0u) { if (xb_ld(&bar[XB_TMO])) break; if (sp > XB_SPIN_CAP) { atomicAdd(&bar[XB_TMO], 1u); break; } }
    }
    nloc = mine > 0u ? mine : 1u; nx = cnt > 0u ? cnt : 1u;
}

__device__ __forceinline__ void xcd_barrier(const XcdBarrier& b) {
    asm volatile("s_waitcnt vmcnt(0)" ::: "memory");
    __syncthreads();
    if (threadIdx.x == 0) {
        unsigned* bar = b.bar;
        __builtin_amdgcn_s_waitcnt(0);
        unsigned nloc = b.st[0], nx = b.st[1];
        if (nloc == 0u) { xcd_barrier_complete(bar, b.x, nloc, nx); b.st[0] = nloc; b.st[1] = nx; }
        const unsigned old = xb_add(&bar[XB_XSUB(b.x)], 1u);
        const unsigned gen = old / nloc;
        if (old + 1u == (gen + 1u) * nloc) {
            __builtin_amdgcn_fence(__ATOMIC_RELEASE, "agent");
            asm volatile("s_waitcnt vmcnt(0)" ::: "memory");
            const unsigned og = xb_add(&bar[XB_TOP], 1u);
            const unsigned tg = og / nx;
            if (og + 1u == (tg + 1u) * nx) xb_add(&bar[XB_TOPGEN], 1u);
            else XB_SPIN(xb_ld(&bar[XB_TOPGEN]) == tg, bar);
            __builtin_amdgcn_fence(__ATOMIC_ACQUIRE, "agent");
            xb_add(&bar[XB_XGEN(b.x)], 1u);
            asm volatile("s_waitcnt vmcnt(0)" ::: "memory");
        } else {
            XB_SPIN(xb_ld(&bar[XB_XGEN(b.x)]) == gen, bar);
            __builtin_amdgcn_fence(__ATOMIC_ACQUIRE, "agent");
            asm volatile("s_waitcnt vmcnt(0)" ::: "memory");
        }
    }
    __syncthreads();
}

struct Frame {
    LAS unsigned char* lds;
    int tid, lane, wave, vcu, G;
};
struct Args { const float* in[12]; float* out; unsigned char* ws; double invf[32]; };

typedef float f32x2v __attribute__((ext_vector_type(2)));
typedef unsigned u32x2v __attribute__((ext_vector_type(2)));
typedef short s16x4 __attribute__((ext_vector_type(4)));

__device__ __forceinline__ float wave_sum(float v) {
#pragma unroll
    for (int o = 1; o < 64; o <<= 1) v += __shfl_xor(v, o);
    return v;
}
__device__ __forceinline__ unsigned cvtpk(float lo, float hi) { return pg8::cvt_pk_bf16(lo, hi); }
__device__ __forceinline__ float bf2f(unsigned short b) { return __builtin_bit_cast(float, (unsigned)b << 16); }
__device__ __forceinline__ float bflo(unsigned w) { return __builtin_bit_cast(float, w << 16); }
__device__ __forceinline__ float bfhi(unsigned w) { return __builtin_bit_cast(float, w & 0xffff0000u); }
__device__ __forceinline__ float xsig(float x, float z) { return x * __builtin_amdgcn_rcpf(1.0f + __builtin_amdgcn_exp2f(-1.4426950408889634f * z)); }
__device__ __forceinline__ float silu_f(float x) { return xsig(x, x); }
__device__ __forceinline__ float gelu_f(float x) { return xsig(x, 1.5957691216057308f * (x + 0.044715f * x * x * x)); }

__device__ __forceinline__ int dest_row_in(int n) { if (n >= 2 * DA) return n; const int l = n & 63, hb = n & ~63; return hb + (l < 32 ? 2 * l : 2 * (l - 32) + 1); }
__device__ __forceinline__ void p0_transpose_item(const float* W, int K, int N, bf16* WT, const float* gk, bool perm, LAS float* scr, int item, int lane) {
    const int nblk = N / 32, kb = item / nblk, nb = item % nblk, k0 = 64 * kb, n0 = 32 * nb;
#pragma unroll 8
    for (int i = 0; i < 32; ++i) { const int kk = 2 * i + (lane >> 5); float w = W[(size_t)(k0 + kk) * N + n0 + (lane & 31)]; if (gk) w *= gk[k0 + kk]; scr[kk * 33 + (lane & 31)] = w; }
    LDS_WAIT(); asm volatile("" ::: "memory");
    const int c = lane & 7;
#pragma unroll
    for (int j = 0; j < 4; ++j) { const int n = (lane >> 3) + 8 * j; const LAS float* s = scr + (8 * c) * 33 + n;
        v4u o; o.x = pk2(s[0 * 33], s[1 * 33]); o.y = pk2(s[2 * 33], s[3 * 33]); o.z = pk2(s[4 * 33], s[5 * 33]); o.w = pk2(s[6 * 33], s[7 * 33]);
        const int dr = perm ? dest_row_in(n0 + n) : (n0 + n);
        *(GAS v4u*)(WT + (size_t)dr * K + k0 + 8 * c) = o; }
    LDS_WAIT(); asm volatile("" ::: "memory");
}
__device__ __forceinline__ void rms_row_to_bf16(int lane, const float* xrow, bf16* orow) {
    GAS unsigned long long* o8 = (GAS unsigned long long*)orow + lane;
    if (xrow == nullptr) {
#pragma unroll
        for (int j = 0; j < 8; ++j) o8[64 * j] = 0ull;
        return;
    }
    const GAS f32x4* xr = (const GAS f32x4*)xrow + lane;
    f32x4 v[8]; float s = 0.f;
#pragma unroll
    for (int j = 0; j < 8; ++j) { v[j] = xr[64 * j]; s += (v[j].x * v[j].x + v[j].y * v[j].y) + (v[j].z * v[j].z + v[j].w * v[j].w); }
    const float r = 1.0f / sqrtf(wave_sum(s) * (1.0f / DM) + EPS);
#pragma unroll
    for (int j = 0; j < 8; ++j) o8[64 * j] = (unsigned long long)pk2(v[j].x * r, v[j].y * r) | ((unsigned long long)pk2(v[j].z * r, v[j].w * r) << 32);
}
__device__ __forceinline__ void p0_prologue(const Frame& F, const Args& A) {
    unsigned char* ws = A.ws;
    LAS float* scr = (LAS float*)(F.lds + F.wave * 16384);
    const int gw = F.vcu * NWAVES + F.wave, NGW = F.G * NWAVES;
    constexpr int I_IN = (DM / 64) * (DIN / 32), I_OUT = (DM / 64) * (DM / 32);
    for (int it = gw; it < I_IN + I_OUT; it += NGW) {
        if (it < I_IN) p0_transpose_item(A.in[5], DM, DIN, (bf16*)(ws + WS_WIN), A.in[4], true, scr, it, F.lane);
        else p0_transpose_item(A.in[10], DM, DM, (bf16*)(ws + WS_WOUT), nullptr, false, scr, it - I_IN, F.lane);
    }
    for (int m = gw; m < MP; m += NGW) {
        const float* xrow = m < SEQ ? A.in[0] + (size_t)m * DM : (m < MROWS ? A.in[1] + (size_t)(m - SEQ) * DM : nullptr);
        rms_row_to_bf16(F.lane, xrow, (bf16*)(ws + WS_XN) + (size_t)m * DM);
    }
    const int gt = gw * 64 + F.lane, NGT = NGW * 64;
    float* rope = (float*)(ws + WS_ROPE);
    for (int e = gt; e < NSLOT * 32; e += NGT) {
        const int slot = e >> 5, i = e & 31;
        const int pos = slot < SEQ ? slot : PAST + (slot - SEQ);
        const double ang = (double)pos * A.invf[i];
        const double kq = rint(ang * 0.15915494309189535);
        double r = fma(-kq, 6.283185307179586, ang); r = fma(-kq, 2.4492935982947064e-16, r);
        const float rf = (float)r;
        f32x2v cs; cs.x = cosf(rf); cs.y = sinf(rf);
        *(f32x2v*)(rope + 2 * (size_t)e) = cs;
    }
    {
        v4u z; z.x = 0u; z.y = 0u; z.z = 0u; z.w = 0u;
        for (int e = gt; e < PADR * DA / 8; e += NGT) { *(v4u*)(ws + WS_K + (size_t)e * 16) = z; *(v4u*)(ws + WS_V + (size_t)e * 16) = z; }
    }
    bf16* wmp = (bf16*)(ws + WS_WMP);
    for (int e = gt; e < 8 * 128 * 128; e += NGT) {
        const int kp = e & 127, t = (e >> 7) & 127, g = e >> 14;
        const int ss = kp >> 5, q = (kp >> 3) & 3, j = kp & 7, s = 32 * ss + 16 * (j >> 2) + 4 * q + (j & 3);
        const float w = s <= t ? A.in[8][(size_t)(g * 128 + t) * 128 + s] : 0.f;
        wmp[e] = (bf16)f2bf(w);
    }
}

struct EpiIn {
    static constexpr bool PERM = true, AFTER_DRAIN = false;
    bf16 *Q, *K, *V, *GA, *U, *GV, *GB;
    const float* rope; float* stats; float* out; float* qs;
    __device__ __forceinline__ void operator()(const pg8::f32x4 (&acc)[2][2][4][2], const pg8::Unit& u, int wr, int wc, int fr, int fq) const {
        const int sec = u.pn >> 2;
        const int col0 = (u.pn & 3) * 256 + wc * 32 + 8 * fq;
        const int row0 = u.pm * 256 + wr * 64 + fr;
        if (sec <= 1) {
            bf16* dstb = sec == 0 ? Q : K;
            const float sc = sec == 0 ? QSCALE : 1.0f;
#pragma unroll
            for (int ai = 0; ai < 2; ++ai)
#pragma unroll
                for (int m = 0; m < 4; ++m) {
                    const int row = row0 + ai * 128 + m * 16;
                    const int slot = row < SEQ ? row : SEQ + ((row - SEQ) & 3);
                    float* fdst = nullptr;
                    if (sec == 1) { if (row >= TAIL0 && row < SEQ) fdst = out + OFF_KT + (size_t)(row - TAIL0) * DA; else if (row >= SEQ && row < MROWS) fdst = out + OFF_KS + (size_t)(row - SEQ) * DA; }
                    else { if (row >= SEQ && row < MROWS) fdst = qs + (size_t)(row - SEQ) * DA; }
#pragma unroll
                    for (int bj = 0; bj < 2; ++bj) {
                        const int cl = col0 + bj * 128, hb = cl & ~63, i0 = (cl & 63) >> 1;
                        const float* tp = rope + ((size_t)slot * 32 + i0) * 2;
                        const f32x4 t0 = *(const f32x4*)tp, t1 = *(const f32x4*)(tp + 4);
                        const f32x4 v0 = acc[ai][bj][m][0], v1 = acc[ai][bj][m][1];
                        f32x4 y1, y2;
                        y1[0] = (v0[0] * t0[0] - v0[1] * t0[1]) * sc; y2[0] = (v0[1] * t0[0] + v0[0] * t0[1]) * sc;
                        y1[1] = (v0[2] * t0[2] - v0[3] * t0[3]) * sc; y2[1] = (v0[3] * t0[2] + v0[2] * t0[3]) * sc;
                        y1[2] = (v1[0] * t1[0] - v1[1] * t1[1]) * sc; y2[2] = (v1[1] * t1[0] + v1[0] * t1[1]) * sc;
                        y1[3] = (v1[2] * t1[2] - v1[3] * t1[3]) * sc; y2[3] = (v1[3] * t1[2] + v1[2] * t1[3]) * sc;
                        v4u w; w.x = cvtpk(y1[0], y2[0]); w.y = cvtpk(y1[1], y2[1]); w.z = cvtpk(y1[2], y2[2]); w.w = cvtpk(y1[3], y2[3]);
                        *(v4u*)(dstb + (size_t)row * DA + cl) = w;
                        if (fdst) { *(f32x4*)(fdst + hb + i0) = y1; *(f32x4*)(fdst + hb + 32 + i0) = y2; }
                    }
                }
        } else if (sec == 2) {
#pragma unroll
            for (int ai = 0; ai < 2; ++ai)
#pragma unroll
                for (int m = 0; m < 4; ++m) {
                    const int row = row0 + ai * 128 + m * 16;
                    float* fdst = nullptr;
                    if (row >= TAIL0 && row < SEQ) fdst = out + OFF_VT + (size_t)(row - TAIL0) * DA; else if (row >= SEQ && row < MROWS) fdst = out + OFF_VS + (size_t)(row - SEQ) * DA;
#pragma unroll
                    for (int bj = 0; bj < 2; ++bj) {
                        const int cl = col0 + bj * 128;
                        const f32x4 v0 = acc[ai][bj][m][0], v1 = acc[ai][bj][m][1];
                        v4u w; w.x = cvtpk(v0[0], v0[1]); w.y = cvtpk(v0[2], v0[3]); w.z = cvtpk(v1[0], v1[1]); w.w = cvtpk(v1[2], v1[3]);
                        *(v4u*)(V + (size_t)row * DA + cl) = w;
                        if (fdst) { *(f32x4*)(fdst + cl) = v0; *(f32x4*)(fdst + cl + 4) = v1; }
                    }
                }
        } else if (sec == 3 || sec == 6) {
            bf16* dstb = sec == 3 ? GA : GB;
#pragma unroll
            for (int ai = 0; ai < 2; ++ai)
#pragma unroll
                for (int m = 0; m < 4; ++m) {
                    const int row = row0 + ai * 128 + m * 16;
#pragma unroll
                    for (int bj = 0; bj < 2; ++bj) {
                        const int cl = col0 + bj * 128;
                        const f32x4 v0 = acc[ai][bj][m][0], v1 = acc[ai][bj][m][1];
                        v4u w; w.x = cvtpk(silu_f(v0[0]), silu_f(v0[1])); w.y = cvtpk(silu_f(v0[2]), silu_f(v0[3])); w.z = cvtpk(silu_f(v1[0]), silu_f(v1[1])); w.w = cvtpk(silu_f(v1[2]), silu_f(v1[3]));
                        *(v4u*)(dstb + (size_t)row * DA + cl) = w;
                    }
                }
        } else {
            bf16* dstb = sec == 4 ? U : GV;
#pragma unroll
            for (int ai = 0; ai < 2; ++ai)
#pragma unroll
                for (int m = 0; m < 4; ++m) {
                    const int row = row0 + ai * 128 + m * 16;
                    float s1 = 0.f, s2 = 0.f;
#pragma unroll
                    for (int bj = 0; bj < 2; ++bj) {
                        const int cl = col0 + bj * 128;
                        f32x4 v0 = acc[ai][bj][m][0], v1 = acc[ai][bj][m][1];
#pragma unroll
                        for (int e = 0; e < 4; ++e) { v0[e] = gelu_f(v0[e]); v1[e] = gelu_f(v1[e]); s1 += v0[e] + v1[e]; s2 += v0[e] * v0[e] + v1[e] * v1[e]; }
                        v4u w; w.x = cvtpk(v0[0], v0[1]); w.y = cvtpk(v0[2], v0[3]); w.z = cvtpk(v1[0], v1[1]); w.w = cvtpk(v1[2], v1[3]);
                        *(v4u*)(dstb + (size_t)row * DA + cl) = w;
                    }
                    if (sec == 5) {
                        s1 += __shfl_xor(s1, 16); s1 += __shfl_xor(s1, 32); s2 += __shfl_xor(s2, 16); s2 += __shfl_xor(s2, 32);
                        if (fq == 0) { f32x2v p; p.x = s1; p.y = s2; *(f32x2v*)(stats + ((size_t)row * 16 + (u.pn & 3) * 4 + wc) * 2) = p; }
                    }
                }
        }
    }
};

struct EpiOut {
    static constexpr bool PERM = false, AFTER_DRAIN = false;
    const float* xp; const float* xs; float* out; float* ssq;
    __device__ __forceinline__ void operator()(const pg8::f32x4 (&acc)[2][2][4][2], const pg8::Unit& u, int wr, int wc, int fr, int fq) const {
        const int row0 = u.pm * 256 + wr * 64 + fr, col0 = u.pn * 256 + wc * 32 + 4 * fq;
#pragma unroll
        for (int ai = 0; ai < 2; ++ai) {
            if (u.pm * 256 + ai * 128 >= MROWS) continue;
#pragma unroll
            for (int m = 0; m < 4; ++m) {
                const int row = row0 + ai * 128 + m * 16;
                const float* xr = row < SEQ ? xp + (size_t)row * DM : xs + (size_t)(row - SEQ) * DM;
                float* orow = out + (size_t)row * DM;
                float ss = 0.f;
#pragma unroll
                for (int bj = 0; bj < 2; ++bj)
#pragma unroll
                    for (int n = 0; n < 2; ++n) {
                        const int col = col0 + bj * 128 + n * 16;
                        const f32x4 r = *(const f32x4*)(xr + col) + acc[ai][bj][m][n];
                        *(f32x4*)(orow + col) = r;
                        ss += (r[0] * r[0] + r[1] * r[1]) + (r[2] * r[2] + r[3] * r[3]);
                    }
                ss += __shfl_xor(ss, 16); ss += __shfl_xor(ss, 32);
                if (fq == 0) ssq[(size_t)row * 32 + u.pn * 4 + wc] = ss;
            }
        }
    }
};

typedef short v4i16_t __attribute__((ext_vector_type(4)));
__device__ __forceinline__ s16x4 ldtr(LAS const unsigned char* p) { return __builtin_bit_cast(s16x4, __builtin_amdgcn_ds_read_tr16_b64_v4i16((LAS v4i16_t*)p)); }
#define MFMA16(a, b, c) __builtin_amdgcn_mfma_f32_16x16x32_bf16((a), (b), (c), 0, 0, 0)

struct P2Ptrs { const bf16 *Q, *K, *V, *GA, *U, *GV, *GB, *WMP; const float* stats; bf16* AC; const float *ck, *cv, *ksn, *vsn, *qs, *ln_g, *ln_b, *w_s, *b_s; float* vc_out; };

#define ATT_WAITV(n) asm volatile("s_waitcnt vmcnt(" #n ")" ::: "memory")
__device__ __forceinline__ void glds16(const GAS unsigned char* gsrc, unsigned lds_dst) { unsigned keep;
    asm volatile("s_mov_b32 %0, m0\n\ts_mov_b32 m0, %2\n\ts_nop 0\n\tglobal_load_lds_dwordx4 %1, off\n\ts_mov_b32 m0, %0" : "=&s"(keep) : "v"(gsrc), "s"(lds_dst) : "memory"); }
__device__ __forceinline__ void attn_item(const Frame& F, const P2Ptrs& T, int h, int P0) {
    const int lane = F.lane, w = F.wave, q16 = lane & 15, g = lane >> 4;
    LAS float* ACC = (LAS float*)(F.lds + L_ACC);
    LAS float* ML = (LAS float*)(F.lds + L_ML);
    LAS unsigned char* VB = F.lds + L_VB + w * 8192;
    const unsigned vbase = (unsigned)(uintptr_t)VB;
    const GAS unsigned char* Qh = (const GAS unsigned char*)(T.Q + h * HDIM);
    const GAS unsigned char* Kh = (const GAS unsigned char*)(T.K + (size_t)PADR * DA + h * HDIM);
    const GAS unsigned char* Vh = (const GAS unsigned char*)(T.V + (size_t)PADR * DA + h * HDIM);
    const int jr = lane >> 3, jc = (lane & 7) ^ (((lane >> 4) & 3) << 1);
    const int qq = q16 >> 2, pp = q16 & 3, fh = 2 * (g & 1) + (qq >> 1);
    int tro[4];
#pragma unroll
    for (int n = 0; n < 4; ++n) tro[n] = (4 * g + qq) * 128 + (2 * (n ^ fh) + (pp >> 1)) * 16 + 8 * (pp & 1);
    bf16x8 kf[18], qf0, qf1;
#define ATT_GEOM(idx_, d_, qrel0_) const int d_ = (idx_) < 2 ? 1 : ((idx_) < 4 ? 4 : 16); const int tau_##d_ = 2 * w + ((idx_) & 1); \
        const int qrel0_ = (idx_) < 2 ? 16 * tau_##d_ : ((idx_) < 4 ? (tau_##d_ & 3) + 64 * (tau_##d_ >> 2) : tau_##d_);
#define ATT_LOADKQ(d_, pb_) do { const unsigned vo_ = (unsigned)((d_) * q16) * (DA * 2) + 16 * g; \
        const GAS unsigned char* qb_ = Qh + (size_t)(pb_) * (DA * 2); qf0 = *(const GAS bf16x8*)(qb_ + vo_); qf1 = *(const GAS bf16x8*)(qb_ + vo_ + 64); \
        _Pragma("unroll") for (int kt = 1; kt < 10; ++kt) { const GAS unsigned char* kb_ = Kh + (long)((pb_) + (d_) * (16 * kt - 144)) * (DA * 2); \
            kf[2 * kt - 2] = *(const GAS bf16x8*)(kb_ + vo_); kf[2 * kt - 1] = *(const GAS bf16x8*)(kb_ + vo_ + 64); } } while (0)
#define ATT_DMAV(d_, pb_, s_, buf_) do { const unsigned vo_ = (unsigned)((d_) * jr) * (DA * 2) + 16 * jc; \
        _Pragma("unroll") for (int i = 0; i < 4; ++i) { const GAS unsigned char* vb_ = Vh + (long)((pb_) + (d_) * (32 * (s_) + 8 * i - 144)) * (DA * 2); \
            glds16((const GAS unsigned char*)(vb_ + vo_), (unsigned)__builtin_amdgcn_readfirstlane((int)(vbase + (buf_) * 4096 + i * 1024))); } } while (0)
    { ATT_GEOM(0, d0, qr0); ATT_DMAV(d0, P0 + qr0, 0, 0); ATT_DMAV(d0, P0 + qr0, 1, 1); ATT_LOADKQ(d0, P0 + qr0); }
#pragma unroll 1
    for (int idx = 0; idx < 6; ++idx) {
        ATT_GEOM(idx, d, qrel0);
        const int pb = P0 + qrel0;
        f32x4 st[10];
#pragma unroll
        for (int kt = 1; kt < 10; ++kt) {
            const f32x4 a = MFMA16(kf[2 * kt - 2], qf0, ((f32x4){0.f, 0.f, 0.f, 0.f}));
            st[kt] = MFMA16(kf[2 * kt - 1], qf1, a);
        }
        const float NEG = -INFINITY;
#pragma unroll
        for (int r = 0; r < 4; ++r) { const int rk = 4 * g + r; if (rk < q16) st[1][r] = NEG; if (rk > q16) st[9][r] = NEG; }
        if (pb < 128 * d) {
#pragma unroll
            for (int kt = 1; kt < 10; ++kt)
#pragma unroll
                for (int r = 0; r < 4; ++r) if (pb + d * (16 * kt + 4 * g + r - 144) < 0) st[kt][r] = NEG;
        }
        float mx = NEG;
#pragma unroll
        for (int kt = 1; kt < 10; ++kt) mx = fmaxf(fmaxf(fmaxf(st[kt][0], st[kt][1]), fmaxf(st[kt][2], st[kt][3])), mx);
        mx = fmaxf(mx, __shfl_xor(mx, 16)); mx = fmaxf(mx, __shfl_xor(mx, 32));
        float ls = 0.f;
#pragma unroll
        for (int kt = 1; kt < 10; ++kt)
#pragma unroll
            for (int r = 0; r < 4; ++r) { const float e = __builtin_amdgcn_exp2f(st[kt][r] - mx); st[kt][r] = e; ls += e; }
        ls += __shfl_xor(ls, 16); ls += __shfl_xor(ls, 32);
        v4u pw[5];
        pw[0].x = 0u; pw[0].y = 0u; pw[0].z = cvtpk(st[1][0], st[1][1]); pw[0].w = cvtpk(st[1][2], st[1][3]);
#pragma unroll
        for (int s = 1; s < 5; ++s) { pw[s].x = cvtpk(st[2 * s][0], st[2 * s][1]); pw[s].y = cvtpk(st[2 * s][2], st[2 * s][3]); pw[s].z = cvtpk(st[2 * s + 1][0], st[2 * s + 1][1]); pw[s].w = cvtpk(st[2 * s + 1][2], st[2 * s + 1][3]); }
        __builtin_amdgcn_sched_barrier(0);
        ATT_WAITV(0);
        ATT_GEOM(idx + 1, dn, qrn);
        const int pbn = P0 + qrn;
        if (idx < 5) { ATT_LOADKQ(dn, pbn); }
        __builtin_amdgcn_sched_barrier(0);
        f32x4 o[4];
#pragma unroll
        for (int n = 0; n < 4; ++n) o[n] = (f32x4){0.f, 0.f, 0.f, 0.f};
#pragma unroll
        for (int s = 0; s < 5; ++s) {
            if (s == 2 || s == 3) ATT_WAITV(4);
            else if (s == 4) { ATT_WAITV(0);
#pragma unroll
                for (int i = 0; i < 18; ++i) asm volatile("" :: "v"(kf[i]));
                asm volatile("" :: "v"(qf0), "v"(qf1)); }
            const bf16x8 pf = __builtin_bit_cast(bf16x8, pw[s]);
            LAS unsigned char* vb = VB + (s & 1) * 4096;
            s16x4 lo[4], hi[4];
#pragma unroll
            for (int n = 0; n < 4; ++n) { lo[n] = ldtr(vb + tro[n]); hi[n] = ldtr(vb + tro[n] + 2048); }
            __builtin_amdgcn_sched_barrier(0);
#pragma unroll
            for (int n = 0; n < 4; ++n) {
                const bf16x8 vf = (bf16x8){lo[n][0], lo[n][1], lo[n][2], lo[n][3], hi[n][0], hi[n][1], hi[n][2], hi[n][3]};
                o[n] = MFMA16(pf, vf, o[n]);
            }
            asm volatile("s_waitcnt lgkmcnt(0)" ::: "memory");
            if (s < 3) { ATT_DMAV(d, pb, s + 2, s & 1); }
            else if (s == 4 && idx < 5) { ATT_DMAV(dn, pbn, 0, 0); ATT_DMAV(dn, pbn, 1, 1); }
            __builtin_amdgcn_sched_barrier(0);
        }
        const int p = idx >> 1;
#pragma unroll
        for (int r = 0; r < 4; ++r) {
            const int rho = 4 * g + r;
            const float mp = __shfl(mx, rho), lp = __shfl(ls, rho);
            const int qrel = qrel0 + d * rho;
            LAS float* arow = ACC + qrel * ACC_STRIDE + q16;
            if (p == 0) {
#pragma unroll
                for (int n = 0; n < 4; ++n) arow[16 * n] = o[n][r];
                if (q16 == 0) { ML[2 * qrel] = mp; ML[2 * qrel + 1] = lp; }
            } else {
                const float mo = ML[2 * qrel], lo_ = ML[2 * qrel + 1];
                const float mn = fmaxf(mo, mp), ao = __builtin_amdgcn_exp2f(mo - mn), ap = __builtin_amdgcn_exp2f(mp - mn), ln = lo_ * ao + lp * ap;
                if (p == 1) {
#pragma unroll
                    for (int n = 0; n < 4; ++n) arow[16 * n] = arow[16 * n] * ao + o[n][r] * ap;
                    if (q16 == 0) { ML[2 * qrel] = mn; ML[2 * qrel + 1] = ln; }
                } else {
                    const float inv = 1.0f / ln;
#pragma unroll
                    for (int n = 0; n < 4; ++n) arow[16 * n] = (arow[16 * n] * ao + o[n][r] * ap) * inv;
                }
            }
        }
        if (idx & 1) asm volatile("s_waitcnt lgkmcnt(0)\n\ts_barrier" ::: "memory");
    }
#undef ATT_GEOM
#undef ATT_LOADKQ
#undef ATT_DMAV
#pragma unroll
    for (int i = 0; i < 4; ++i) {
        const int idx = F.tid + 512 * i, qrel = idx >> 3, c8 = idx & 7;
        const LAS float* ar = ACC + qrel * ACC_STRIDE + 8 * c8;
        const f32x4 a0 = *(const LAS f32x4*)ar, a1 = *(const LAS f32x4*)(ar + 4);
        const v4u gw = *(const v4u*)(T.GA + (size_t)(P0 + qrel) * DA + h * HDIM + 8 * c8);
        v4u o; o.x = cvtpk(a0[0] * bflo(gw.x), a0[1] * bfhi(gw.x)); o.y = cvtpk(a0[2] * bflo(gw.y), a0[3] * bfhi(gw.y));
        o.z = cvtpk(a1[0] * bflo(gw.z), a1[1] * bfhi(gw.z)); o.w = cvtpk(a1[2] * bflo(gw.w), a1[3] * bfhi(gw.w));
        *(v4u*)(T.AC + (size_t)(P0 + qrel) * DM + h * HDIM + 8 * c8) = o;
    }
    __syncthreads();
}

__device__ __forceinline__ void gmlp_item(const Frame& F, const P2Ptrs& T, int ck, int gi) {
    const int lane = F.lane, w = F.wave, q16 = lane & 15, g = lane >> 4, tid = F.tid;
    LAS unsigned char* IMG = F.lds;
    LAS f32x2v* RS = (LAS f32x2v*)(F.lds + 32768);
    LAS float* OUTB = (LAS float*)(F.lds + 36864);
    const int r0 = ck * 128, ch0 = gi * 128;
    const int c8 = tid & 15, s0 = tid >> 4;
    v4u gvr[4];
#pragma unroll
    for (int i = 0; i < 4; ++i) gvr[i] = *(const GAS v4u*)(T.GV + (size_t)(r0 + s0 + 32 * i) * DA + ch0 + 8 * c8);
    const f32x4 lg0 = *(const GAS f32x4*)(T.ln_g + ch0 + 8 * c8), lg1 = *(const GAS f32x4*)(T.ln_g + ch0 + 8 * c8 + 4);
    const f32x4 lb0 = *(const GAS f32x4*)(T.ln_b + ch0 + 8 * c8), lb1 = *(const GAS f32x4*)(T.ln_b + ch0 + 8 * c8 + 4);
    if (tid < 128) {
        const GAS float* sp = (const GAS float*)T.stats + (size_t)(r0 + tid) * 32; float s1 = 0.f, s2 = 0.f;
#pragma unroll
        for (int i = 0; i < 8; ++i) { const f32x4 v = *(const GAS f32x4*)(sp + 4 * i); s1 += v[0] + v[2]; s2 += v[1] + v[3]; }
        const float mu = s1 * (1.0f / DA), var = fmaxf(s2 * (1.0f / DA) - mu * mu, 0.f);
        f32x2v o; o.x = mu; o.y = 1.0f / sqrtf(var + EPS); RS[tid] = o;
    }
    bf16x8 af[20];
    {
        const GAS bf16* wm = (const GAS bf16*)T.WMP + (size_t)gi * 128 * 128 + (size_t)q16 * 128 + 8 * g;
        int k = 0;
#pragma unroll
        for (int tt = 0; tt < 8; ++tt)
#pragma unroll
            for (int ss = 0; ss < 4; ++ss) if (ss <= (tt >> 1)) { af[k] = *(const GAS bf16x8*)(wm + (size_t)tt * 16 * 128 + 32 * ss); ++k; }
    }
    __syncthreads();
#pragma unroll
    for (int i = 0; i < 4; ++i) {
        const int s = s0 + 32 * i;
        const f32x2v ms = RS[s];
        const v4u gv = gvr[i];
        v4u o;
        o.x = cvtpk((bflo(gv.x) - ms.x) * ms.y * lg0[0] + lb0[0], (bfhi(gv.x) - ms.x) * ms.y * lg0[1] + lb0[1]);
        o.y = cvtpk((bflo(gv.y) - ms.x) * ms.y * lg0[2] + lb0[2], (bfhi(gv.y) - ms.x) * ms.y * lg0[3] + lb0[3]);
        o.z = cvtpk((bflo(gv.z) - ms.x) * ms.y * lg1[0] + lb1[0], (bfhi(gv.z) - ms.x) * ms.y * lg1[1] + lb1[1]);
        o.w = cvtpk((bflo(gv.w) - ms.x) * ms.y * lg1[2] + lb1[2], (bfhi(gv.w) - ms.x) * ms.y * lg1[3] + lb1[3]);
        *(LAS v4u*)(IMG + (c8 >> 1) * 4096 + s * 32 + (c8 & 1) * 16) = o;
    }
    v4u ur[4], gbr[4]; float bs[4];
#pragma unroll
    for (int i = 0; i < 4; ++i) {
        const size_t row = (size_t)(r0 + s0 + 32 * i);
        ur[i] = *(const GAS v4u*)(T.U + row * DA + ch0 + 8 * c8); gbr[i] = *(const GAS v4u*)(T.GB + row * DA + ch0 + 8 * c8);
        bs[i] = *((const GAS float*)T.b_s + gi * 128 + s0 + 32 * i);
    }
    __syncthreads();
    {
        bf16x8 bfr[4];
        const int troff = w * 4096 + (4 * g + (q16 >> 2)) * 32 + (q16 & 3) * 8;
#pragma unroll
        for (int ss = 0; ss < 4; ++ss) {
            const s16x4 lo = ldtr(IMG + troff + ss * 1024), hi = ldtr(IMG + troff + ss * 1024 + 512);
            bfr[ss] = (bf16x8){lo[0], lo[1], lo[2], lo[3], hi[0], hi[1], hi[2], hi[3]};
        }
        int k = 0;
#pragma unroll
        for (int tt = 0; tt < 8; ++tt) {
            f32x4 acc = (f32x4){0.f, 0.f, 0.f, 0.f};
#pragma unroll
            for (int ss = 0; ss < 4; ++ss) if (ss <= (tt >> 1)) { acc = MFMA16(af[k], bfr[ss], acc); ++k; }
#pragma unroll
            for (int r = 0; r < 4; ++r) OUTB[(16 * tt + 4 * g + r) * 132 + 16 * w + q16] = acc[r];
        }
    }
    __syncthreads();
#pragma unroll
    for (int i = 0; i < 4; ++i) {
        const int t = s0 + 32 * i;
        const LAS float* ob = OUTB + t * 132 + 8 * c8;
        const f32x4 m0 = *(const LAS f32x4*)ob + bs[i], m1 = *(const LAS f32x4*)(ob + 4) + bs[i];
        const v4u uv = ur[i], gb = gbr[i];
        v4u o;
        o.x = cvtpk(bflo(uv.x) * m0[0] * bflo(gb.x), bfhi(uv.x) * m0[1] * bfhi(gb.x)); o.y = cvtpk(bflo(uv.y) * m0[2] * bflo(gb.y), bfhi(uv.y) * m0[3] * bfhi(gb.y));
        o.z = cvtpk(bflo(uv.z) * m1[0] * bflo(gb.z), bfhi(uv.z) * m1[1] * bfhi(gb.z)); o.w = cvtpk(bflo(uv.w) * m1[2] * bflo(gb.w), bfhi(uv.w) * m1[3] * bfhi(gb.w));
        *(GAS v4u*)(T.AC + (size_t)(r0 + t) * DM + DA + ch0 + 8 * c8) = o;
    }
    __syncthreads();
}

__device__ __forceinline__ void sattn_item(const Frame& F, const P2Ptrs& T, int si) {
    const int lane = F.lane, w = F.wave, kk = lane >> 2, part = lane & 3;
    const int b = si >> 6, h = (si >> 2) & 15, t = si & 3;
    LAS float* SC = (LAS float*)(F.lds + w * 2048);
    const float* qp = T.qs + (size_t)(b * 4 + t) * DA + h * HDIM + 4 * part;
    f32x4 qv[4];
#pragma unroll
    for (int i = 0; i < 4; ++i) qv[i] = *(const f32x4*)(qp + 16 * i);
    float mx = -INFINITY;
#pragma unroll 1
    for (int p = 0; p < 3; ++p) {
        const int d = p == 0 ? 1 : (p == 1 ? 4 : 16);
#pragma unroll 3
        for (int ps = 0; ps < 9; ++ps) {
            const int j = ps * 16 + kk, jj = j > 128 ? 128 : j, idx = WBUF + t - jj * d;
            const float* kr = idx >= WBUF ? T.ksn + ((size_t)(b * 4 + idx - WBUF) * NHEAD + h) * HDIM : T.ck + ((size_t)(b * WBUF + idx) * NHEAD + h) * HDIM;
            kr += 4 * part;
            float s = 0.f;
#pragma unroll
            for (int i = 0; i < 4; ++i) { const f32x4 kv = *(const f32x4*)(kr + 16 * i); s += (qv[i][0] * kv[0] + qv[i][1] * kv[1]) + (qv[i][2] * kv[2] + qv[i][3] * kv[3]); }
            s += __shfl_xor(s, 1); s += __shfl_xor(s, 2);
            if (j > 128) s = -INFINITY;
            if (part == 0) SC[p * 144 + ps * 16 + kk] = s;
            mx = fmaxf(mx, s);
        }
    }
    mx = fmaxf(mx, __shfl_xor(mx, 4)); mx = fmaxf(mx, __shfl_xor(mx, 8)); mx = fmaxf(mx, __shfl_xor(mx, 16)); mx = fmaxf(mx, __shfl_xor(mx, 32));
    f32x4 o[4]; float ls = 0.f;
#pragma unroll
    for (int i = 0; i < 4; ++i) o[i] = (f32x4){0.f, 0.f, 0.f, 0.f};
#pragma unroll 1
    for (int p = 0; p < 3; ++p) {
        const int d = p == 0 ? 1 : (p == 1 ? 4 : 16);
#pragma unroll 3
        for (int ps = 0; ps < 9; ++ps) {
            const int j = ps * 16 + kk, jj = j > 128 ? 128 : j, idx = WBUF + t - jj * d;
            const float* vr = idx >= WBUF ? T.vsn + ((size_t)(b * 4 + idx - WBUF) * NHEAD + h) * HDIM : T.cv + ((size_t)(b * WBUF + idx) * NHEAD + h) * HDIM;
            vr += 4 * part;
            const float pe = __builtin_amdgcn_exp2f(SC[p * 144 + ps * 16 + kk] - mx);
            ls += pe;
#pragma unroll
            for (int i = 0; i < 4; ++i) { const f32x4 vv = *(const f32x4*)(vr + 16 * i); o[i] += vv * pe; }
        }
    }
#pragma unroll
    for (int sh = 4; sh < 64; sh <<= 1) {
        ls += __shfl_xor(ls, sh);
#pragma unroll
        for (int i = 0; i < 4; ++i)
#pragma unroll
            for (int e = 0; e < 4; ++e) o[i][e] += __shfl_xor(o[i][e], sh);
    }
    if (kk == 0) {
        const float inv = 1.0f / ls;
        const size_t row = (size_t)(SEQ + b * 4 + t);
#pragma unroll
        for (int i = 0; i < 4; ++i) {
            const int c = h * HDIM + 16 * i + 4 * part;
            const u32x2v gw = *(const u32x2v*)(T.GA + row * DA + c);
            u32x2v ov; ov.x = cvtpk(o[i][0] * inv * bflo(gw.x), o[i][1] * inv * bfhi(gw.x)); ov.y = cvtpk(o[i][2] * inv * bflo(gw.y), o[i][3] * inv * bfhi(gw.y));
            *(u32x2v*)(T.AC + row * DM + c) = ov;
        }
    }
}

__device__ __forceinline__ void sgmlp_item(const Frame& F, const P2Ptrs& T, int b) {
    const int lane = F.lane;
    float mu[4], rs[4];
    {
        const f32x2v pr = *(const f32x2v*)(T.stats + ((size_t)(SEQ + b * 4 + (lane >> 4)) * 16 + (lane & 15)) * 2);
        float s1 = pr.x, s2 = pr.y;
#pragma unroll
        for (int o = 1; o < 16; o <<= 1) { s1 += __shfl_xor(s1, o); s2 += __shfl_xor(s2, o); }
        const float m_ = s1 * (1.0f / DA), var = fmaxf(s2 * (1.0f / DA) - m_ * m_, 0.f), r_ = 1.0f / sqrtf(var + EPS);
#pragma unroll
        for (int t = 0; t < 4; ++t) { mu[t] = __shfl(m_, 16 * t); rs[t] = __shfl(r_, 16 * t); }
    }
#pragma unroll 1
    for (int hh = 0; hh < 2; ++hh) {
        const int ch = hh * 512 + lane * 8, gi = ch >> 7;
        float lg[8], lb[8];
#pragma unroll
        for (int e = 0; e < 8; ++e) { lg[e] = T.ln_g[ch + e]; lb[e] = T.ln_b[ch + e]; }
        float vn[4][8];
#pragma unroll
        for (int t = 0; t < 4; ++t) {
            const size_t row = (size_t)(SEQ + b * 4 + t);
            const v4u gv = *(const v4u*)(T.GV + row * DA + ch);
            const unsigned wv[4] = {gv.x, gv.y, gv.z, gv.w};
#pragma unroll
            for (int e = 0; e < 4; ++e) { vn[t][2 * e] = (bflo(wv[e]) - mu[t]) * rs[t] * lg[2 * e] + lb[2 * e]; vn[t][2 * e + 1] = (bfhi(wv[e]) - mu[t]) * rs[t] * lg[2 * e + 1] + lb[2 * e + 1]; }
            float* vo = T.vc_out + (size_t)(b * 4 + t) * DA + ch;
            *(f32x4*)vo = (f32x4){vn[t][0], vn[t][1], vn[t][2], vn[t][3]}; *(f32x4*)(vo + 4) = (f32x4){vn[t][4], vn[t][5], vn[t][6], vn[t][7]};
        }
#pragma unroll
        for (int t = 0; t < 4; ++t) {
            const size_t row = (size_t)(SEQ + b * 4 + t);
            float mix[8];
            const float bias = T.b_s[gi * 128 + t];
#pragma unroll
            for (int e = 0; e < 8; ++e) mix[e] = bias;
#pragma unroll
            for (int s = 0; s < 4; ++s) if (s <= t) { const float wts = T.w_s[(size_t)(gi * 128 + t) * 128 + s];
#pragma unroll
                for (int e = 0; e < 8; ++e) mix[e] += wts * vn[s][e]; }
            const v4u uv = *(const v4u*)(T.U + row * DA + ch), gb = *(const v4u*)(T.GB + row * DA + ch);
            v4u o;
            o.x = cvtpk(bflo(uv.x) * mix[0] * bflo(gb.x), bfhi(uv.x) * mix[1] * bfhi(gb.x)); o.y = cvtpk(bflo(uv.y) * mix[2] * bflo(gb.y), bfhi(uv.y) * mix[3] * bfhi(gb.y));
            o.z = cvtpk(bflo(uv.z) * mix[4] * bflo(gb.z), bfhi(uv.z) * mix[5] * bfhi(gb.z)); o.w = cvtpk(bflo(uv.w) * mix[6] * bflo(gb.w), bfhi(uv.w) * mix[7] * bfhi(gb.w));
            *(v4u*)(T.AC + row * DM + DA + ch) = o;
        }
    }
}


__device__ __forceinline__ void sout_item(const Frame& F, const bf16* AC, const bf16* WoT, const float* xs, float* out, float* ssq, int rt, int ct) {
    const int lane = F.lane, w = F.wave, q16 = lane & 15, g = lane >> 4, tid = F.tid;
    LAS float* RED = (LAS float*)F.lds;
    const GAS unsigned char* ab = (const GAS unsigned char*)(AC + (size_t)(SEQ + 16 * rt + q16) * DM + 256 * w + 8 * g);
    const GAS unsigned char* bb = (const GAS unsigned char*)(WoT + (size_t)(64 * ct + q16) * DM + 256 * w + 8 * g);
    bf16x8 af[8];
#pragma unroll
    for (int ks = 0; ks < 8; ++ks) af[ks] = *(const GAS bf16x8*)(ab + 64 * ks);
    f32x4 acc[4];
#pragma unroll
    for (int nb = 0; nb < 4; ++nb) {
        bf16x8 bf_[8];
#pragma unroll
        for (int ks = 0; ks < 8; ++ks) bf_[ks] = *(const GAS bf16x8*)(bb + (size_t)nb * 16 * DM * 2 + 64 * ks);
        f32x4 a = (f32x4){0.f, 0.f, 0.f, 0.f};
#pragma unroll
        for (int ks = 0; ks < 8; ++ks) a = MFMA16(af[ks], bf_[ks], a);
        acc[nb] = a;
    }
#pragma unroll
    for (int nb = 0; nb < 4; ++nb)
#pragma unroll
        for (int r = 0; r < 4; ++r) RED[(w * 16 + 4 * g + r) * 64 + 16 * nb + q16] = acc[nb][r];
    __syncthreads();
    {
        const int row = tid >> 5, c2 = (tid & 31) * 2;
        float s0 = 0.f, s1 = 0.f;
#pragma unroll
        for (int ww = 0; ww < 8; ++ww) { const f32x2v v = *(const LAS f32x2v*)(RED + (ww * 16 + row) * 64 + c2); s0 += v.x; s1 += v.y; }
        const size_t grow = (size_t)(SEQ + 16 * rt + row);
        const f32x2v xr = *(const f32x2v*)(xs + (size_t)(16 * rt + row) * DM + 64 * ct + c2);
        f32x2v y; y.x = xr.x + s0; y.y = xr.y + s1;
        *(f32x2v*)(out + grow * DM + 64 * ct + c2) = y;
        float ss = y.x * y.x + y.y * y.y;
#pragma unroll
        for (int o = 1; o < 32; o <<= 1) ss += __shfl_xor(ss, o);
        if ((tid & 31) == 0) ssq[grow * 32 + ct] = ss;
    }
    __syncthreads();
}

__device__ __forceinline__ void p2_mixers(const Frame& F, const P2Ptrs& T) {
    for (int it = F.vcu; it < 512 * REP_ATT; it += F.G) attn_item(F, T, (it & 511) >> 5, (it & 31) * 256);
    for (int it = F.vcu; it < 512; it += F.G) gmlp_item(F, T, it >> 3, it & 7);
#if REP_GMLP > 1
    for (int it = F.vcu; it < 512; it += F.G) gmlp_item(F, T, it >> 3, it & 7);
#endif
    const int gw = F.vcu * NWAVES + F.wave, NGW = F.G * NWAVES;
    for (int si = gw; si < 2048; si += NGW) sattn_item(F, T, si);
#if REP_SATT > 1
    for (int si = gw; si < 2048; si += NGW) sattn_item(F, T, si);
#endif
    for (int b = gw; b < 32; b += NGW) sgmlp_item(F, T, b);
}

__device__ __forceinline__ void p4_final(const Frame& F, const float* yin, float* out, const float* ssq, const float* fg) {
    const int gw = F.vcu * NWAVES + F.wave, NGW = F.G * NWAVES, lane = F.lane;
    f32x4 gv[8];
#pragma unroll
    for (int j = 0; j < 8; ++j) gv[j] = *((const f32x4*)fg + 64 * j + lane);
    for (int m = gw; m < MROWS; m += NGW) {
        float s = lane < 32 ? ssq[(size_t)m * 32 + lane] : 0.f;
        s = wave_sum(s);
        const float r = 1.0f / sqrtf(s * (1.0f / DM) + EPS);
        const f32x4* yi = (const f32x4*)(yin + (size_t)m * DM) + lane; f32x4* yr = (f32x4*)(out + (size_t)m * DM) + lane;
#pragma unroll
        for (int j = 0; j < 8; ++j) { const f32x4 v = yi[64 * j]; yr[64 * j] = v * r * gv[j]; }
    }
}


__global__ void __launch_bounds__(NWAVES * 64, 2) hybrid_fwd(Args args) {
    extern __shared__ __attribute__((aligned(16))) unsigned char lds[];
    Frame F;
    F.lds = (LAS unsigned char*)lds;
    F.tid = threadIdx.x; F.lane = F.tid & 63; F.wave = __builtin_amdgcn_readfirstlane(F.tid >> 6);
    F.G = gridDim.x; { const int bx = blockIdx.x; F.vcu = (F.G % 8 == 0) ? (bx % 8) * (F.G / 8) + bx / 8 : bx; }
    unsigned char* ws = args.ws;
#ifdef Y_BUF
    float* const YPRE = (float*)(ws + WS_Y);
#else
    float* const YPRE = args.out;
#endif
    volatile LAS unsigned* MISC = (volatile LAS unsigned*)(F.lds + MISC_OFF);
    if (F.tid < 64) MISC[F.tid] = 0u;
    __syncthreads();
    XcdBarrier bar = xcd_barrier_post((unsigned*)(ws + WS_CTL) + CW_BAR, MISC + 8);

#ifndef SKIP_P0
    p0_prologue(F, args);
#endif
#if REP_P0 > 1
    p0_prologue(F, args);
#endif
    xcd_barrier(bar);
#if REP_BAR > 1
    xcd_barrier(bar);
#endif

#ifndef SKIP_P1
    for (int rep = 0; rep < REP_P1; ++rep) {
        pg8::Gemm g{(const pg8::bf16_t*)(ws + WS_XN), (const pg8::bf16_t*)(ws + WS_WIN), MP, DIN, DM};
        pg8::StaticOrder S; S.init(MP, DIN, F.G, (int)blockIdx.x);
        EpiIn E{(bf16*)(ws + WS_Q), (bf16*)(ws + WS_K) + (size_t)PADR * DA, (bf16*)(ws + WS_V) + (size_t)PADR * DA, (bf16*)(ws + WS_GA), (bf16*)(ws + WS_U), (bf16*)(ws + WS_GV), (bf16*)(ws + WS_GB),
                (const float*)(ws + WS_ROPE), (float*)(ws + WS_STATS), args.out, (float*)(ws + WS_QS)};
        pg8::gemm_phase<EpiIn, pg8::StaticOrder, true, true>(F.lds, g, S, E);
    }
    xcd_barrier(bar);
#if REP_BAR > 1
    xcd_barrier(bar);
#endif

#endif
#ifndef SKIP_P2
    {
        P2Ptrs T{(const bf16*)(ws + WS_Q), (const bf16*)(ws + WS_K), (const bf16*)(ws + WS_V), (const bf16*)(ws + WS_GA), (const bf16*)(ws + WS_U), (const bf16*)(ws + WS_GV), (const bf16*)(ws + WS_GB),
                 (const bf16*)(ws + WS_WMP), (const float*)(ws + WS_STATS), (bf16*)(ws + WS_AC), args.in[2], args.in[3], args.out + OFF_KS, args.out + OFF_VS, (const float*)(ws + WS_QS),
                 args.in[6], args.in[7], args.in[8], args.in[9], args.out + OFF_VC};
        p2_mixers(F, T);
    }
    xcd_barrier(bar);
#if REP_BAR > 1
    xcd_barrier(bar);
#endif

#endif
#ifndef SKIP_P3
    for (int it = F.vcu; it < 256; it += F.G) sout_item(F, (const bf16*)(ws + WS_AC), (const bf16*)(ws + WS_WOUT), args.in[1], YPRE, (float*)(ws + WS_SS), it >> 5, it & 31);
    for (int rep = 0; rep < REP_P3; ++rep) {
        pg8::Gemm g{(const pg8::bf16_t*)(ws + WS_AC), (const pg8::bf16_t*)(ws + WS_WOUT), SEQ, DM, DM};
        pg8::StaticOrder S; S.init(SEQ, DM, F.G, (int)blockIdx.x);
        EpiOut E{args.in[0], args.in[1], YPRE, (float*)(ws + WS_SS)};
        pg8::gemm_phase<EpiOut, pg8::StaticOrder, true, true>(F.lds, g, S, E);
    }
    xcd_barrier(bar);
#if REP_BAR > 1
    xcd_barrier(bar);
#endif

#endif
    p4_final(F, YPRE, args.out, (const float*)(ws + WS_SS), args.in[11]);
#if REP_P4 > 1
    p4_final(F, YPRE, args.out, (const float*)(ws + WS_SS), args.in[11]);
#endif
}

extern "C" void kernel_launch(void* const* d_in, const int* in_sizes, int n_in, void* d_out, int out_size, void* d_ws, size_t ws_size, hipStream_t stream) {
    static int grid = 0;
    if (grid == 0) {
        if (n_in != 12 || out_size != (int)OUT_TOTAL || ws_size < WS_END) { fprintf(stderr, "kernel_launch: unexpected shapes (n_in %d out %d ws %zu)\n", n_in, out_size, ws_size); grid = -1; return; }
        int dev = 0, cus = 0, per_cu = 0;
        if (hipGetDevice(&dev) != hipSuccess || hipDeviceGetAttribute(&cus, hipDeviceAttributeMultiprocessorCount, dev) != hipSuccess) { grid = -1; return; }
        if (hipFuncSetAttribute((const void*)hybrid_fwd, hipFuncAttributeMaxDynamicSharedMemorySize, LDS_BYTES) != hipSuccess) { fprintf(stderr, "kernel_launch: hipFuncSetAttribute failed\n"); grid = -1; return; }
        if (hipOccupancyMaxActiveBlocksPerMultiprocessor(&per_cu, (const void*)hybrid_fwd, NWAVES * 64, LDS_BYTES) != hipSuccess || per_cu < 1) { fprintf(stderr, "kernel_launch: occupancy query reports %d blocks per CU\n", per_cu); (void)hipGetLastError(); grid = -1; return; }
        grid = cus;
    }
    if (grid < 0) return;
    if (hipMemsetAsync((char*)d_ws + WS_CTL, 0, CTL_ZERO_BYTES, stream) != hipSuccess) return;
    Args a{};
    for (int i = 0; i < 12; ++i) a.in[i] = (const float*)d_in[i];
    a.out = (float*)d_out; a.ws = (unsigned char*)d_ws;
    for (int i = 0; i < 32; ++i) a.invf[i] = exp(-log(10000.0) * (double)i / 32.0);
    hipLaunchKernelGGL(hybrid_fwd, dim3(grid), dim3(NWAVES * 64), LDS_BYTES, stream, a);
}
```

```cpp
#include <hip/hip_runtime.h>
#include <cstdio>
#include <cstdint>
#include <cmath>

namespace pg8 {
#define PG8_LAS __attribute__((address_space(3)))
typedef unsigned short bf16_t;
typedef short bf16x8 __attribute__((ext_vector_type(8)));
typedef float f32x4 __attribute__((ext_vector_type(4)));
typedef unsigned u32x4 __attribute__((ext_vector_type(4)));
constexpr int BM = 256, BK = 64, HALF = 128, HTB = HALF * BK * 2  , STAGE_BYTES = 8 * HTB, NXCD = 8, WGM = 8;

__host__ __device__ __forceinline__ int lds_byte(int r, int c) { const int st = (r >> 4) * 2 + (c >> 5), rr = r & 15, cc = c & 31, ob = rr * 64 + cc * 2; return st * 1024 + (ob ^ (((ob >> 9) & 1) << 5)); }
__host__ __device__ __forceinline__ void stage_rc(int b, int& R, int& C) { const int st = b / 1024, sb = b % 1024, swz = sb ^ (((sb >> 9) & 1) << 5); R = (st >> 1) * 16 + swz / 64; C = (st & 1) * 32 + (swz % 64) / 2; }
__host__ __device__ __forceinline__ int perm32(int rho) { const int n = rho >> 4, i = rho & 15; return 8 * (i >> 2) + 4 * n + (i & 3); }

struct Unit { int pm, pn; };
struct Gemm { const bf16_t* A; const bf16_t* Bt; int M, N, K; };

struct StaticOrder {
    int nM, nN, nwg, G, c;
    __host__ __device__ void init(int M, int N, int G_, int c_) { nM = M / BM; nN = N / BM; nwg = nM * nN; G = G_; c = c_; }
    __host__ __device__ bool next(int i, Unit& u) const {
        const long L = (long)i * G + c; if (L >= nwg) return false;
        int wgid = (int)L; { const int q = nwg / NXCD, r = nwg % NXCD, xcd = wgid % NXCD, off = wgid / NXCD; wgid = (xcd < r ? xcd * (q + 1) : r * (q + 1) + (xcd - r) * q) + off; }
        const int nig = WGM * nN, gid = wgid / nig, fm = gid * WGM, gsz = (nM - fm) < WGM ? (nM - fm) : WGM;
        u.pm = fm + ((wgid % nig) % gsz); u.pn = (wgid % nig) / gsz; return true;
    }
    __device__ __forceinline__ void a_ready(const Unit&) const {}
    __device__ __forceinline__ void done(const Unit&) const {}
};
__device__ __forceinline__ unsigned cvt_pk_bf16(float lo, float hi) { unsigned r; asm volatile("v_cvt_pk_bf16_f32 %0, %1, %2" : "=v"(r) : "v"(lo), "v"(hi)); return r; }
template <class Epi, class Sched, bool ALIGN_EPI = false, bool SP2 = false>
__device__ __forceinline__ void gemm_phase(PG8_LAS unsigned char* lds, const Gemm g, const Sched& S, const Epi& E) {
    const int tid = threadIdx.x, wid = __builtin_amdgcn_readfirstlane(tid >> 6), lane = tid & 63, wr = wid >> 2, wc = wid & 3, fr = lane & 15, fq = lane >> 4;
    const int K = g.K, nt = K / BK;
    unsigned voffA[2], voffB[2];
#pragma unroll
    for (int i = 0; i < 2; ++i) { int R, C; stage_rc(tid * 16 + i * 8192, R, C); const int Rb = Epi::PERM ? ((R & ~31) + perm32(R & 31)) : R;
        voffA[i] = (unsigned)(R * K + C) * 2u; voffB[i] = (unsigned)(Rb * K + C) * 2u; }
    const size_t kstep = (size_t)(BK * 2);
    const size_t hstep = (size_t)HALF * K * 2;
    const size_t tstep = 2 * hstep;
    const unsigned ldsw = (unsigned)wid * 1024u;
    const int aoff = lds_byte(wr * 64 + fr, fq * 8), boff = lds_byte(wc * 32 + fr, fq * 8);
#define PG8_SA(b, h) (((b) * 2 + (h)) * HTB)
#define PG8_SB(b, h) ((4 + (b) * 2 + (h)) * HTB)
#define PG8_STAGE(bufoff, gbase, voff) do { _Pragma("unroll") for (int _i = 0; _i < 2; ++_i) \
        __builtin_amdgcn_global_load_lds((const unsigned*)((const char*)(gbase) + (voff)[_i]), (PG8_LAS unsigned*)(lds + (bufoff) + ldsw + _i * 8192), 16, 0, 0); } while (0)
#define PG8_LDA(dst, b, h) do { _Pragma("unroll") for (int m = 0; m < 4; ++m) _Pragma("unroll") for (int k = 0; k < 2; ++k) dst[m][k] = *(const PG8_LAS bf16x8*)(lds + PG8_SA(b, h) + aoff + m * 2048 + k * 1024); } while (0)
#define PG8_LDB(dst, b, h) do { _Pragma("unroll") for (int n = 0; n < 2; ++n) _Pragma("unroll") for (int k = 0; k < 2; ++k) dst[n][k] = *(const PG8_LAS bf16x8*)(lds + PG8_SB(b, h) + boff + n * 2048 + k * 1024); } while (0)
#define PG8_MMA(ai, bj, At, Bt) do { __builtin_amdgcn_s_setprio(1); _Pragma("unroll") for (int m = 0; m < 4; ++m) _Pragma("unroll") for (int n = 0; n < 2; ++n) _Pragma("unroll") for (int k = 0; k < 2; ++k) \
        acc[ai][bj][m][n] = __builtin_amdgcn_mfma_f32_16x16x32_bf16(Bt[n][k], At[m][k], acc[ai][bj][m][n], 0, 0, 0); __builtin_amdgcn_s_setprio(0); } while (0)
#define PG8_WAIT_V(n) asm volatile("s_waitcnt vmcnt(" #n ")" ::: "memory")
#define PG8_WAIT_L(n) asm volatile("s_waitcnt lgkmcnt(" #n ")" ::: "memory")
#define PG8_BAR __builtin_amdgcn_s_barrier()
#define PG8_SCHED __builtin_amdgcn_sched_barrier(0)
    Unit cur, nxt; int ui = 0;
    if (!S.next(0, cur)) return;
    f32x4 acc[2][2][4][2];
#pragma unroll
    for (int a = 0; a < 2; ++a)
#pragma unroll
        for (int b = 0; b < 2; ++b)
#pragma unroll
            for (int m = 0; m < 4; ++m)
#pragma unroll
                for (int n = 0; n < 2; ++n) acc[a][b][m][n] = (f32x4){0.f, 0.f, 0.f, 0.f};
    bf16x8 At[4][2], B0[2][2], B1[2][2];
    const char* cA = (const char*)g.A + (size_t)cur.pm * tstep; const char* cB = (const char*)g.Bt + (size_t)cur.pn * tstep;
    S.a_ready(cur);
    if constexpr (SP2) {
        PG8_STAGE(PG8_SB(0, 0), cB, voffB); PG8_STAGE(PG8_SB(0, 1), cB + hstep, voffB); PG8_STAGE(PG8_SA(0, 0), cA, voffA); PG8_STAGE(PG8_SA(0, 1), cA + hstep, voffA);
        if (wr == 1) PG8_BAR;
        PG8_WAIT_V(2); PG8_BAR;
        PG8_STAGE(PG8_SB(1, 0), cB + kstep, voffB); PG8_STAGE(PG8_SA(1, 0), cA + kstep, voffA); PG8_STAGE(PG8_SB(1, 1), cB + hstep + kstep, voffB);
        PG8_WAIT_V(6); PG8_BAR;
    } else {
        PG8_STAGE(PG8_SB(0, 0), cB, voffB); PG8_STAGE(PG8_SA(0, 0), cA, voffA); PG8_STAGE(PG8_SB(0, 1), cB + hstep, voffB); PG8_STAGE(PG8_SA(0, 1), cA + hstep, voffA);
        if (wr == 1) PG8_BAR;
        PG8_WAIT_V(4); PG8_BAR;
        PG8_STAGE(PG8_SB(1, 0), cB + kstep, voffB); PG8_STAGE(PG8_SA(1, 0), cA + kstep, voffA); PG8_STAGE(PG8_SB(1, 1), cB + hstep + kstep, voffB);
        PG8_WAIT_V(6); PG8_BAR;
    }
    for (;;) {
        const bool has_next = S.next(ui + 1, nxt);
        const char* nA = has_next ? (const char*)g.A + (size_t)nxt.pm * tstep : cA; const char* nB = has_next ? (const char*)g.Bt + (size_t)nxt.pn * tstep : cB;
        for (int t = 0; t < nt; t += 2) {
            const bool last = (t == nt - 2);
            const char* a1 = cA + (size_t)(t + 1) * kstep;
            const char* a2 = last ? nA : cA + (size_t)(t + 2) * kstep; const char* b2 = last ? nB : cB + (size_t)(t + 2) * kstep;
            const char* a3 = a2 + kstep; const char* b3 = b2 + kstep;
            if (last && has_next) S.a_ready(nxt);
            if constexpr (SP2) {
            PG8_LDB(B0, 0, 0); PG8_LDB(B1, 0, 1); PG8_SCHED; PG8_LDA(At, 0, 0); PG8_STAGE(PG8_SA(1, 1), a1 + hstep, voffA);
            PG8_WAIT_V(8); PG8_WAIT_L(0); PG8_BAR; PG8_MMA(0, 0, At, B0); PG8_MMA(0, 1, At, B1); PG8_BAR; PG8_SCHED;
            PG8_LDA(At, 0, 1); PG8_STAGE(PG8_SB(0, 0), b2, voffB); PG8_STAGE(PG8_SB(0, 1), b2 + hstep, voffB); PG8_STAGE(PG8_SA(0, 0), a2, voffA);
            PG8_WAIT_V(8); PG8_WAIT_L(0); PG8_BAR; PG8_MMA(1, 0, At, B0); PG8_MMA(1, 1, At, B1); PG8_BAR; PG8_SCHED;
            PG8_LDB(B0, 1, 0); PG8_LDB(B1, 1, 1); PG8_SCHED; PG8_LDA(At, 1, 0); PG8_STAGE(PG8_SA(0, 1), a2 + hstep, voffA);
            PG8_WAIT_V(8); PG8_WAIT_L(0); PG8_BAR; PG8_MMA(0, 0, At, B0); PG8_MMA(0, 1, At, B1); PG8_BAR; PG8_SCHED;
            PG8_LDA(At, 1, 1); PG8_STAGE(PG8_SB(1, 0), b3, voffB); PG8_STAGE(PG8_SB(1, 1), b3 + hstep, voffB); PG8_STAGE(PG8_SA(1, 0), a3, voffA);
            PG8_WAIT_V(8); PG8_WAIT_L(0); PG8_BAR; PG8_MMA(1, 0, At, B0); PG8_MMA(1, 1, At, B1); PG8_BAR; PG8_SCHED;
            } else {
            PG8_LDB(B0, 0, 0); PG8_SCHED; PG8_LDA(At, 0, 0); PG8_STAGE(PG8_SA(1, 1), a1 + hstep, voffA);
            PG8_WAIT_L(8); PG8_BAR; PG8_WAIT_L(0); PG8_MMA(0, 0, At, B0); PG8_BAR; PG8_SCHED;
            PG8_LDB(B1, 0, 1); PG8_STAGE(PG8_SB(0, 0), b2, voffB);
            PG8_BAR; PG8_WAIT_L(0); PG8_MMA(0, 1, At, B1); PG8_BAR;
            PG8_LDA(At, 0, 1); PG8_STAGE(PG8_SA(0, 0), a2, voffA);
            PG8_BAR; PG8_WAIT_L(0); PG8_MMA(1, 0, At, B0); PG8_BAR; PG8_SCHED;
            PG8_STAGE(PG8_SB(0, 1), b2 + hstep, voffB);
            PG8_WAIT_V(6); PG8_BAR; PG8_MMA(1, 1, At, B1); PG8_BAR;
            PG8_LDB(B0, 1, 0); PG8_SCHED; PG8_LDA(At, 1, 0); PG8_STAGE(PG8_SA(0, 1), a2 + hstep, voffA);
            PG8_WAIT_L(8); PG8_BAR; PG8_WAIT_L(0); PG8_MMA(0, 0, At, B0); PG8_BAR; PG8_SCHED;
            PG8_LDB(B1, 1, 1); PG8_STAGE(PG8_SB(1, 0), b3, voffB);
            PG8_BAR; PG8_WAIT_L(0); PG8_MMA(0, 1, At, B1); PG8_BAR;
            PG8_LDA(At, 1, 1); PG8_STAGE(PG8_SA(1, 0), a3, voffA);
            PG8_BAR; PG8_WAIT_L(0); PG8_MMA(1, 0, At, B0); PG8_BAR; PG8_SCHED;
            PG8_STAGE(PG8_SB(1, 1), b3 + hstep, voffB);
            PG8_WAIT_V(6); PG8_BAR; PG8_MMA(1, 1, At, B1); PG8_BAR;
            }
        }
        if constexpr (ALIGN_EPI) { if (wr == 0) PG8_BAR; }
        if constexpr (!Epi::AFTER_DRAIN) { E(acc, cur, wr, wc, fr, fq); S.done(cur); }
        if (!has_next) break;
#pragma unroll
        for (int a = 0; a < 2; ++a)
#pragma unroll
            for (int b = 0; b < 2; ++b)
#pragma unroll
                for (int m = 0; m < 4; ++m)
#pragma unroll
                    for (int n = 0; n < 2; ++n) acc[a][b][m][n] = (f32x4){0.f, 0.f, 0.f, 0.f};
        cur = nxt; cA = nA; cB = nB; ++ui;
        if constexpr (ALIGN_EPI) { if (wr == 1) PG8_BAR; }
    }
    PG8_WAIT_V(0);
    if constexpr (!ALIGN_EPI) { if (wr == 0) PG8_BAR; }
    PG8_BAR;
    if constexpr (Epi::AFTER_DRAIN) { E.fused(acc, cur, wr, wc, fr, fq, lds, wid, lane); S.done(cur); }
#undef PG8_SA
#undef PG8_SB
#undef PG8_STAGE
#undef PG8_LDA
#undef PG8_LDB
#undef PG8_MMA
#undef PG8_WAIT_V
#undef PG8_WAIT_L
#undef PG8_BAR
#undef PG8_SCHED
}
}

#ifndef REP_P0
#define REP_P0 1
#endif
#ifndef REP_P1
#define REP_P1 1
#endif
#ifndef REP_ATT
#define REP_ATT 1
#endif
#ifndef REP_GMLP
#define REP_GMLP 1
#endif
#ifndef REP_SATT
#define REP_SATT 1
#endif
#ifndef REP_P3
#define REP_P3 1
#endif
#ifndef REP_BAR
#define REP_BAR 1
#endif
#ifndef REP_P4
#define REP_P4 1
#endif

constexpr int NWAVES = 8;
constexpr int DM = 2048, SEQ = 8192, NSAMP = 128, MROWS = SEQ + NSAMP  , MP = 8448  , DIN = 7168, DA = 1024, NHEAD = 16, HDIM = 64;
constexpr int WBUF = 2048, TAIL0 = SEQ - 2048, PAST = 16384, NSLOT = SEQ + 4;
constexpr float EPS = 1e-6f;
constexpr float QSCALE = 0.125f * 1.4426950408889634f;
constexpr size_t OFF_YP = 0, OFF_YS = 16777216, OFF_KT = 17039360, OFF_VT = 19136512, OFF_KS = 21233664, OFF_VS = 21364736, OFF_VC = 21495808, OUT_TOTAL = 21626880;

constexpr size_t MiB = 1u << 20;
constexpr size_t WS_CTL = 0, CTL_ZERO_BYTES = 1 * MiB;
constexpr size_t WS_WIN = 2 * MiB, WS_WOUT = 30 * MiB, WS_XN = 38 * MiB, WS_ROPE = 71 * MiB;
constexpr int PADR = 2304;
constexpr size_t WS_Q = 74 * MiB, WS_K = 91 * MiB, WS_V = 112 * MiB, WS_GA = 133 * MiB, WS_U = 150 * MiB, WS_GV = 167 * MiB, WS_GB = 184 * MiB;
constexpr size_t WS_STATS = 201 * MiB, WS_AC = 203 * MiB, WS_SS = 236 * MiB, WS_WMP = 238 * MiB, WS_QS = 239 * MiB, WS_Y = 240 * MiB, WS_END = 308 * MiB;
static_assert((size_t)(MP + PADR) * DA * 2 <= 21 * MiB, "K / V with padding rows");
constexpr int CW_BAR = 4096;

constexpr int LDS_BYTES = 147456;
constexpr int MISC_OFF = LDS_BYTES - 256;
constexpr int ACC_STRIDE = 68;
constexpr int L_ACC = 0, L_ML = 256 * ACC_STRIDE * 4  , L_VB = L_ML + 2048  , L_END_ATT = L_VB + NWAVES * 8192;
static_assert(L_END_ATT <= MISC_OFF, "LDS map");

#define GAS __attribute__((address_space(1)))
#define LAS __attribute__((address_space(3)))
typedef unsigned short bf16;
typedef unsigned v4u __attribute__((ext_vector_type(4)));
typedef float f32x4 __attribute__((ext_vector_type(4)));
typedef short bf16x8 __attribute__((ext_vector_type(8)));
typedef GAS unsigned gu32;
typedef GAS unsigned long long gu64;
#define RLX_AGENT __ATOMIC_RELAXED, __HIP_MEMORY_SCOPE_AGENT
#define LDS_WAIT() asm volatile("s_waitcnt lgkmcnt(0)" ::: "memory")
#define VM_WAIT() asm volatile("s_waitcnt vmcnt(0)" ::: "memory")
__device__ __forceinline__ unsigned long long rt() { return __builtin_amdgcn_s_memrealtime(); }
__device__ __forceinline__ unsigned f2bf(float f) { unsigned u = __builtin_bit_cast(unsigned, f); return (u + 0x7fffu + ((u >> 16) & 1u)) >> 16; }
__device__ __forceinline__ unsigned pk2(float lo, float hi) { return f2bf(lo) | (f2bf(hi) << 16); }
#define XB_TMO      128
#define XB_XCNT(j)  (256  + 64 * (j))
#define XB_XSUB(j)  (1280 + 64 * (j))
#define XB_XGEN(j)  (2304 + 64 * (j))
#define XB_TOP      3328
#define XB_TOPGEN   3392
#define XCD_BAR_WORDS 3456
#define XB_SPIN_CAP (1u << 18)

__device__ __forceinline__ unsigned xb_ld(unsigned* p)              { return __hip_atomic_load(p, __ATOMIC_RELAXED, __HIP_MEMORY_SCOPE_AGENT); }
__device__ __forceinline__ unsigned xb_add(unsigned* p, unsigned v) { return __hip_atomic_fetch_add(p, v, __ATOMIC_RELAXED, __HIP_MEMORY_SCOPE_AGENT); }
__device__ __forceinline__ unsigned xb_xcc_id() { return (unsigned)__builtin_amdgcn_s_getreg((3 << 11) | 20) & 0xFu; }
#define XB_SPIN(cond, bar) do { unsigned _sp = 0; while (cond) { __builtin_amdgcn_s_sleep(1); \
    if ((++_sp & 255u) == 0u) { if (xb_ld(&(bar)[XB_TMO])) break; if (_sp > XB_SPIN_CAP) { atomicAdd(&(bar)[XB_TMO], 1u); break; } } } } while (0)

struct XcdBarrier {
    unsigned* bar; unsigned x;
    volatile LAS unsigned* st;
};

__device__ __forceinline__ XcdBarrier xcd_barrier_post(unsigned* bar, volatile LAS unsigned* st) {
    XcdBarrier b; b.bar = bar; b.x = xb_xcc_id(); b.st = st;
    if (threadIdx.x == 0) (void)xb_add(&bar[XB_XCNT(b.x)], 1u);
    return b;
}
__device__ __forceinline__ void xcd_barrier_complete(unsigned* bar, unsigned x, unsigned& nloc, unsigned& nx) {
    const unsigned G = gridDim.x * gridDim.y * gridDim.z;
    unsigned sum, cnt, mine, sp = 0u;
    for (;;) {
        sum = 0u; cnt = 0u; mine = 0u;
#pragma unroll
        for (unsigned j = 0; j < 16; ++j) { const unsigned c = xb_ld(&bar[XB_XCNT(j)]); sum += c; cnt += (c > 0u) ? 1u : 0u; mine = (j == x) ? c : mine; }
        if (sum == G) break;
        __builtin_amdgcn_s_sleep(1);
        if ((++sp & 255u) == 0u) { if (xb_ld(&bar[XB_TMO])) break; if (sp > XB_SPIN_CAP) { atomicAdd(&bar[XB_TMO], 1u); break; } }
    }
    nloc = mine > 0u ? mine : 1u; nx = cnt > 0u ? cnt : 1u;
}

__device__ __forceinline__ void xcd_barrier(const XcdBarrier& b) {
    asm volatile("s_waitcnt vmcnt(0)" ::: "memory");
    __syncthreads();
    if (threadIdx.x == 0) {
        unsigned* bar = b.bar;
        __builtin_amdgcn_s_waitcnt(0);
        unsigned nloc = b.st[0], nx = b.st[1];
        if (nloc == 0u) { xcd_barrier_complete(bar, b.x, nloc, nx); b.st[0] = nloc; b.st[1] = nx; }
        const unsigned old = xb_add(&bar[XB_XSUB(b.x)], 1u);
        const unsigned gen = old / nloc;
        if (old + 1u == (gen + 1u) * nloc) {
            __builtin_amdgcn_fence(__ATOMIC_RELEASE, "agent");
            asm volatile("s_waitcnt vmcnt(0)" ::: "memory");
            const unsigned og = xb_add(&bar[XB_TOP], 1u);
            const unsigned tg = og / nx;
            if (og + 1u == (tg + 1u) * nx) xb_add(&bar[XB_TOPGEN], 1u);
            else XB_SPIN(xb_ld(&bar[XB_TOPGEN]) == tg, bar);
            __builtin_amdgcn_fence(__ATOMIC_ACQUIRE, "agent");
            xb_add(&bar[XB_XGEN(b.x)], 1u);
            asm volatile("s_waitcnt vmcnt(0)" ::: "memory");
        } else {
            XB_SPIN(xb_ld(&bar[XB_XGEN(b.x)]) == gen, bar);
            __builtin_amdgcn_fence(__ATOMIC_ACQUIRE, "agent");
            asm volatile("s_waitcnt vmcnt(0)" ::: "memory");
        }
    }
    __syncthreads();
}

struct Frame {
    LAS unsigned char* lds;
    int tid, lane, wave, vcu, G;
};
struct Args { const float* in[12]; float* out; unsigned char* ws; double invf[32]; };

typedef float f32x2v __attribute__((ext_vector_type(2)));
typedef unsigned u32x2v __attribute__((ext_vector_type(2)));
typedef short s16x4 __attribute__((ext_vector_type(4)));

__device__ __forceinline__ float wave_sum(float v) {
#pragma unroll
    for (int o = 1; o < 64; o <<= 1) v += __shfl_xor(v, o);
    return v;
}
__device__ __forceinline__ unsigned cvtpk(float lo, float hi) { return pg8::cvt_pk_bf16(lo, hi); }
__device__ __forceinline__ float bf2f(unsigned short b) { return __builtin_bit_cast(float, (unsigned)b << 16); }
__device__ __forceinline__ float bflo(unsigned w) { return __builtin_bit_cast(float, w << 16); }
__device__ __forceinline__ float bfhi(unsigned w) { return __builtin_bit_cast(float, w & 0xffff0000u); }
__device__ __forceinline__ float xsig(float x, float z) { return x * __builtin_amdgcn_rcpf(1.0f + __builtin_amdgcn_exp2f(-1.4426950408889634f * z)); }
__device__ __forceinline__ float silu_f(float x) { return xsig(x, x); }
__device__ __forceinline__ float gelu_f(float x) { return xsig(x, 1.5957691216057308f * (x + 0.044715f * x * x * x)); }

__device__ __forceinline__ int dest_row_in(int n) { if (n >= 2 * DA) return n; const int l = n & 63, hb = n & ~63; return hb + (l < 32 ? 2 * l : 2 * (l - 32) + 1); }
__device__ __forceinline__ void p0_transpose_item(const float* W, int K, int N, bf16* WT, const float* gk, bool perm, LAS float* scr, int item, int lane) {
    const int nblk = N / 32, kb = item / nblk, nb = item % nblk, k0 = 64 * kb, n0 = 32 * nb;
    const int r = lane >> 3, l8 = lane & 7;
    f32x4 v[8];
#pragma unroll
    for (int i = 0; i < 8; ++i) v[i] = *(const GAS f32x4*)(W + (size_t)(k0 + 8 * i + r) * N + n0 + 4 * l8);
    if (gk) {
        float gv[8];
#pragma unroll
        for (int i = 0; i < 8; ++i) gv[i] = *((const GAS float*)gk + k0 + 8 * i + r);
#pragma unroll
        for (int i = 0; i < 8; ++i) v[i] = v[i] * gv[i];
    }
#pragma unroll
    for (int i = 0; i < 8; ++i) { LAS float* d = scr + (8 * i + r) * 33 + 4 * l8; d[0] = v[i][0]; d[1] = v[i][1]; d[2] = v[i][2]; d[3] = v[i][3]; }
    LDS_WAIT(); asm volatile("" ::: "memory");
    const int c = lane & 7;
#pragma unroll
    for (int j = 0; j < 4; ++j) { const int n = (lane >> 3) + 8 * j; const LAS float* s = scr + (8 * c) * 33 + n;
        v4u o; o.x = pk2(s[0 * 33], s[1 * 33]); o.y = pk2(s[2 * 33], s[3 * 33]); o.z = pk2(s[4 * 33], s[5 * 33]); o.w = pk2(s[6 * 33], s[7 * 33]);
        const int dr = perm ? dest_row_in(n0 + n) : (n0 + n);
        *(GAS v4u*)(WT + (size_t)dr * K + k0 + 8 * c) = o; }
    LDS_WAIT(); asm volatile("" ::: "memory");
}
__device__ __forceinline__ void rms_rows2_to_bf16(int lane, const float* xa, const float* xb, bf16* oa, bf16* ob) {
    GAS unsigned long long* o8a = (GAS unsigned long long*)oa + lane; GAS unsigned long long* o8b = (GAS unsigned long long*)ob + lane;
    f32x4 va[8], vb[8]; float sa = 0.f, sb = 0.f;
    if (xa) {
        const GAS f32x4* xr = (const GAS f32x4*)xa + lane;
#pragma unroll
        for (int j = 0; j < 8; ++j) va[j] = xr[64 * j];
    } else {
#pragma unroll
        for (int j = 0; j < 8; ++j) va[j] = (f32x4){0.f, 0.f, 0.f, 0.f};
    }
    if (xb) {
        const GAS f32x4* xr = (const GAS f32x4*)xb + lane;
#pragma unroll
        for (int j = 0; j < 8; ++j) vb[j] = xr[64 * j];
    } else {
#pragma unroll
        for (int j = 0; j < 8; ++j) vb[j] = (f32x4){0.f, 0.f, 0.f, 0.f};
    }
#pragma unroll
    for (int j = 0; j < 8; ++j) { sa += (va[j].x * va[j].x + va[j].y * va[j].y) + (va[j].z * va[j].z + va[j].w * va[j].w); sb += (vb[j].x * vb[j].x + vb[j].y * vb[j].y) + (vb[j].z * vb[j].z + vb[j].w * vb[j].w); }
    const float ra = 1.0f / sqrtf(wave_sum(sa) * (1.0f / DM) + EPS), rb = 1.0f / sqrtf(wave_sum(sb) * (1.0f / DM) + EPS);
#pragma unroll
    for (int j = 0; j < 8; ++j) o8a[64 * j] = (unsigned long long)pk2(va[j].x * ra, va[j].y * ra) | ((unsigned long long)pk2(va[j].z * ra, va[j].w * ra) << 32);
    if (ob) {
#pragma unroll
        for (int j = 0; j < 8; ++j) o8b[64 * j] = (unsigned long long)pk2(vb[j].x * rb, vb[j].y * rb) | ((unsigned long long)pk2(vb[j].z * rb, vb[j].w * rb) << 32);
    }
}
__device__ __forceinline__ void p0_prologue(const Frame& F, const Args& A) {
    unsigned char* ws = A.ws;
    LAS float* scr = (LAS float*)(F.lds + F.wave * 16384);
    const int gw = F.vcu * NWAVES + F.wave, NGW = F.G * NWAVES;
    constexpr int I_IN = (DM / 64) * (DIN / 32), I_OUT = (DM / 64) * (DM / 32);
    for (int it = gw; it < I_IN + I_OUT; it += NGW) {
        if (it < I_IN) p0_transpose_item(A.in[5], DM, DIN, (bf16*)(ws + WS_WIN), A.in[4], true, scr, it, F.lane);
        else p0_transpose_item(A.in[10], DM, DM, (bf16*)(ws + WS_WOUT), nullptr, false, scr, it - I_IN, F.lane);
    }
    for (int m = gw; m < MP; m += 2 * NGW) {
        const int m2 = m + NGW;
        const float* xa = m < SEQ ? A.in[0] + (size_t)m * DM : (m < MROWS ? A.in[1] + (size_t)(m - SEQ) * DM : nullptr);
        const float* xb = m2 < SEQ ? A.in[0] + (size_t)m2 * DM : (m2 < MROWS ? A.in[1] + (size_t)(m2 - SEQ) * DM : nullptr);
        rms_rows2_to_bf16(F.lane, xa, xb, (bf16*)(ws + WS_XN) + (size_t)m * DM, m2 < MP ? (bf16*)(ws + WS_XN) + (size_t)m2 * DM : nullptr);
    }
    const int gt = gw * 64 + F.lane, NGT = NGW * 64;
    float* rope = (float*)(ws + WS_ROPE);
    for (int e = gt; e < NSLOT * 32; e += NGT) {
        const int slot = e >> 5, i = e & 31;
        const int pos = slot < SEQ ? slot : PAST + (slot - SEQ);
        const double ang = (double)pos * A.invf[i];
        const double kq = rint(ang * 0.15915494309189535);
        double r = fma(-kq, 6.283185307179586, ang); r = fma(-kq, 2.4492935982947064e-16, r);
        const float rf = (float)r;
        f32x2v cs; cs.x = cosf(rf); cs.y = sinf(rf);
        *(f32x2v*)(rope + 2 * (size_t)e) = cs;
    }
    {
        v4u z; z.x = 0u; z.y = 0u; z.z = 0u; z.w = 0u;
        for (int e = gt; e < PADR * DA / 8; e += NGT) { *(v4u*)(ws + WS_K + (size_t)e * 16) = z; *(v4u*)(ws + WS_V + (size_t)e * 16) = z; }
    }
    bf16* wmp = (bf16*)(ws + WS_WMP);
    for (int e = gt; e < 8 * 128 * 128; e += NGT) {
        const int kp = e & 127, t = (e >> 7) & 127, g = e >> 14;
        const int ss = kp >> 5, q = (kp >> 3) & 3, j = kp & 7, s = 32 * ss + 16 * (j >> 2) + 4 * q + (j & 3);
        const float w = s <= t ? A.in[8][(size_t)(g * 128 + t) * 128 + s] : 0.f;
        wmp[e] = (bf16)f2bf(w);
    }
}

struct EpiIn {
    static constexpr bool PERM = true, AFTER_DRAIN = false;
    bf16 *Q, *K, *V, *GA, *U, *GV, *GB;
    const float* rope; float* stats; float* out; float* qs;
    __device__ __forceinline__ void operator()(const pg8::f32x4 (&acc)[2][2][4][2], const pg8::Unit& u, int wr, int wc, int fr, int fq) const {
        const int sec = u.pn >> 2;
        const int col0 = (u.pn & 3) * 256 + wc * 32 + 8 * fq;
        const int row0 = u.pm * 256 + wr * 64 + fr;
        if (sec <= 1) {
            bf16* dstb = sec == 0 ? Q : K;
            const float sc = sec == 0 ? QSCALE : 1.0f;
#pragma unroll
            for (int ai = 0; ai < 2; ++ai)
#pragma unroll
                for (int m = 0; m < 4; ++m) {
                    const int row = row0 + ai * 128 + m * 16;
                    const int slot = row < SEQ ? row : SEQ + ((row - SEQ) & 3);
                    float* fdst = nullptr;
                    if (sec == 1) { if (row >= TAIL0 && row < SEQ) fdst = out + OFF_KT + (size_t)(row - TAIL0) * DA; else if (row >= SEQ && row < MROWS) fdst = out + OFF_KS + (size_t)(row - SEQ) * DA; }
                    else { if (row >= SEQ && row < MROWS) fdst = qs + (size_t)(row - SEQ) * DA; }
#pragma unroll
                    for (int bj = 0; bj < 2; ++bj) {
                        const int cl = col0 + bj * 128, hb = cl & ~63, i0 = (cl & 63) >> 1;
                        const float* tp = rope + ((size_t)slot * 32 + i0) * 2;
                        const f32x4 t0 = *(const f32x4*)tp, t1 = *(const f32x4*)(tp + 4);
                        const f32x4 v0 = acc[ai][bj][m][0], v1 = acc[ai][bj][m][1];
                        f32x4 y1, y2;
                        y1[0] = (v0[0] * t0[0] - v0[1] * t0[1]) * sc; y2[0] = (v0[1] * t0[0] + v0[0] * t0[1]) * sc;
                        y1[1] = (v0[2] * t0[2] - v0[3] * t0[3]) * sc; y2[1] = (v0[3] * t0[2] + v0[2] * t0[3]) * sc;
                        y1[2] = (v1[0] * t1[0] - v1[1] * t1[1]) * sc; y2[2] = (v1[1] * t1[0] + v1[0] * t1[1]) * sc;
                        y1[3] = (v1[2] * t1[2] - v1[3] * t1[3]) * sc; y2[3] = (v1[3] * t1[2] + v1[2] * t1[3]) * sc;
                        v4u w; w.x = cvtpk(y1[0], y2[0]); w.y = cvtpk(y1[1], y2[1]); w.z = cvtpk(y1[2], y2[2]); w.w = cvtpk(y1[3], y2[3]);
                        *(v4u*)(dstb + (size_t)row * DA + cl) = w;
                        if (fdst) { *(f32x4*)(fdst + hb + i0) = y1; *(f32x4*)(fdst + hb + 32 + i0) = y2; }
                    }
                }
        } else if (sec == 2) {
#pragma unroll
            for (int ai = 0; ai < 2; ++ai)
#pragma unroll
                for (int m = 0; m < 4; ++m) {
                    const int row = row0 + ai * 128 + m * 16;
                    float* fdst = nullptr;
                    if (row >= TAIL0 && row < SEQ) fdst = out + OFF_VT + (size_t)(row - TAIL0) * DA; else if (row >= SEQ && row < MROWS) fdst = out + OFF_VS + (size_t)(row - SEQ) * DA;
#pragma unroll
                    for (int bj = 0; bj < 2; ++bj) {
                        const int cl = col0 + bj * 128;
                        const f32x4 v0 = acc[ai][bj][m][0], v1 = acc[ai][bj][m][1];
                        v4u w; w.x = cvtpk(v0[0], v0[1]); w.y = cvtpk(v0[2], v0[3]); w.z = cvtpk(v1[0], v1[1]); w.w = cvtpk(v1[2], v1[3]);
                        *(v4u*)(V + (size_t)row * DA + cl) = w;
                        if (fdst) { *(f32x4*)(fdst + cl) = v0; *(f32x4*)(fdst + cl + 4) = v1; }
                    }
                }
        } else if (sec == 3 || sec == 6) {
            bf16* dstb = sec == 3 ? GA : GB;
#pragma unroll
            for (int ai = 0; ai < 2; ++ai)
#pragma unroll
                for (int m = 0; m < 4; ++m) {
                    const int row = row0 + ai * 128 + m * 16;
#pragma unroll
                    for (int bj = 0; bj < 2; ++bj) {
                        const int cl = col0 + bj * 128;
                        const f32x4 v0 = acc[ai][bj][m][0], v1 = acc[ai][bj][m][1];
                        v4u w; w.x = cvtpk(silu_f(v0[0]), silu_f(v0[1])); w.y = cvtpk(silu_f(v0[2]), silu_f(v0[3])); w.z = cvtpk(silu_f(v1[0]), silu_f(v1[1])); w.w = cvtpk(silu_f(v1[2]), silu_f(v1[3]));
                        *(v4u*)(dstb + (size_t)row * DA + cl) = w;
                    }
                }
        } else {
            bf16* dstb = sec == 4 ? U : GV;
#pragma unroll
            for (int ai = 0; ai < 2; ++ai)
#pragma unroll
                for (int m = 0; m < 4; ++m) {
                    const int row = row0 + ai * 128 + m * 16;
                    float s1 = 0.f, s2 = 0.f;
#pragma unroll
                    for (int bj = 0; bj < 2; ++bj) {
                        const int cl = col0 + bj * 128;
                        f32x4 v0 = acc[ai][bj][m][0], v1 = acc[ai][bj][m][1];
#pragma unroll
                        for (int e = 0; e < 4; ++e) { v0[e] = gelu_f(v0[e]); v1[e] = gelu_f(v1[e]); s1 += v0[e] + v1[e]; s2 += v0[e] * v0[e] + v1[e] * v1[e]; }
                        v4u w; w.x = cvtpk(v0[0], v0[1]); w.y = cvtpk(v0[2], v0[3]); w.z = cvtpk(v1[0], v1[1]); w.w = cvtpk(v1[2], v1[3]);
                        *(v4u*)(dstb + (size_t)row * DA + cl) = w;
                    }
                    if (sec == 5) {
                        s1 += __shfl_xor(s1, 16); s1 += __shfl_xor(s1, 32); s2 += __shfl_xor(s2, 16); s2 += __shfl_xor(s2, 32);
                        if (fq == 0) { f32x2v p; p.x = s1; p.y = s2; *(f32x2v*)(stats + ((size_t)row * 16 + (u.pn & 3) * 4 + wc) * 2) = p; }
                    }
                }
        }
    }
};

struct EpiOut {
    static constexpr bool PERM = false, AFTER_DRAIN = false;
    const float* xp; const float* xs; float* out; float* ssq;
    __device__ __forceinline__ void operator()(const pg8::f32x4 (&acc)[2][2][4][2], const pg8::Unit& u, int wr, int wc, int fr, int fq) const {
        const int row0 = u.pm * 256 + wr * 64 + fr, col0 = u.pn * 256 + wc * 32 + 4 * fq;
#pragma unroll
        for (int ai = 0; ai < 2; ++ai) {
            if (u.pm * 256 + ai * 128 >= MROWS) continue;
#pragma unroll
            for (int m = 0; m < 4; ++m) {
                const int row = row0 + ai * 128 + m * 16;
                const float* xr = row < SEQ ? xp + (size_t)row * DM : xs + (size_t)(row - SEQ) * DM;
                float* orow = out + (size_t)row * DM;
                float ss = 0.f;
#pragma unroll
                for (int bj = 0; bj < 2; ++bj)
#pragma unroll
                    for (int n = 0; n < 2; ++n) {
                        const int col = col0 + bj * 128 + n * 16;
                        const f32x4 r = *(const f32x4*)(xr + col) + acc[ai][bj][m][n];
                        *(f32x4*)(orow + col) = r;
                        ss += (r[0] * r[0] + r[1] * r[1]) + (r[2] * r[2] + r[3] * r[3]);
                    }
                ss += __shfl_xor(ss, 16); ss += __shfl_xor(ss, 32);
                if (fq == 0) ssq[(size_t)row * 32 + u.pn * 4 + wc] = ss;
            }
        }
    }
};

typedef short v4i16_t __attribute__((ext_vector_type(4)));
__device__ __forceinline__ s16x4 ldtr(LAS const unsigned char* p) { return __builtin_bit_cast(s16x4, __builtin_amdgcn_ds_read_tr16_b64_v4i16((LAS v4i16_t*)p)); }
#define MFMA16(a, b, c) __builtin_amdgcn_mfma_f32_16x16x32_bf16((a), (b), (c), 0, 0, 0)

struct P2Ptrs { const bf16 *Q, *K, *V, *GA, *U, *GV, *GB, *WMP; const float* stats; bf16* AC; const float *ck, *cv, *ksn, *vsn, *qs, *ln_g, *ln_b, *w_s, *b_s; float* vc_out; };

#define ATT_WAITV(n) asm volatile("s_waitcnt vmcnt(" #n ")" ::: "memory")
__device__ __forceinline__ void glds16(const GAS unsigned char* gsrc, unsigned lds_dst) { unsigned keep;
    asm volatile("s_mov_b32 %0, m0\n\ts_mov_b32 m0, %2\n\ts_nop 0\n\tglobal_load_lds_dwordx4 %1, off\n\ts_mov_b32 m0, %0" : "=&s"(keep) : "v"(gsrc), "s"(lds_dst) : "memory"); }
__device__ __forceinline__ void attn_item(const Frame& F, const P2Ptrs& T, int h, int P0) {
    const int lane = F.lane, w = F.wave, q16 = lane & 15, g = lane >> 4;
    LAS float* ACC = (LAS float*)(F.lds + L_ACC);
    LAS float* ML = (LAS float*)(F.lds + L_ML);
    LAS unsigned char* VB = F.lds + L_VB + w * 8192;
    const unsigned vbase = (unsigned)(uintptr_t)VB;
    const GAS unsigned char* Qh = (const GAS unsigned char*)(T.Q + h * HDIM);
    const GAS unsigned char* Kh = (const GAS unsigned char*)(T.K + (size_t)PADR * DA + h * HDIM);
    const GAS unsigned char* Vh = (const GAS unsigned char*)(T.V + (size_t)PADR * DA + h * HDIM);
    const int jr = lane >> 3, jc = (lane & 7) ^ (((lane >> 4) & 3) << 1);
    const int qq = q16 >> 2, pp = q16 & 3, fh = 2 * (g & 1) + (qq >> 1);
    int tro[4];
#pragma unroll
    for (int n = 0; n < 4; ++n) tro[n] = (4 * g + qq) * 128 + (2 * (n ^ fh) + (pp >> 1)) * 16 + 8 * (pp & 1);
    bf16x8 kf[18], qf0, qf1;
#define ATT_GEOM(idx_, d_, qrel0_) const int d_ = (idx_) < 2 ? 1 : ((idx_) < 4 ? 4 : 16); const int tau_##d_ = 2 * w + ((idx_) & 1); \
        const int qrel0_ = (idx_) < 2 ? 16 * tau_##d_ : ((idx_) < 4 ? (tau_##d_ & 3) + 64 * (tau_##d_ >> 2) : tau_##d_);
#define ATT_LOADKQ(d_, pb_) do { const unsigned vo_ = (unsigned)((d_) * q16) * (DA * 2) + 16 * g; \
        const GAS unsigned char* qb_ = Qh + (size_t)(pb_) * (DA * 2); qf0 = *(const GAS bf16x8*)(qb_ + vo_); qf1 = *(const GAS bf16x8*)(qb_ + vo_ + 64); \
        _Pragma("unroll") for (int kt = 1; kt < 10; ++kt) { const GAS unsigned char* kb_ = Kh + (long)((pb_) + (d_) * (16 * kt - 144)) * (DA * 2); \
            kf[2 * kt - 2] = *(const GAS bf16x8*)(kb_ + vo_); kf[2 * kt - 1] = *(const GAS bf16x8*)(kb_ + vo_ + 64); } } while (0)
#define ATT_DMAV(d_, pb_, s_, buf_) do { const unsigned vo_ = (unsigned)((d_) * jr) * (DA * 2) + 16 * jc; \
        _Pragma("unroll") for (int i = 0; i < 4; ++i) { const GAS unsigned char* vb_ = Vh + (long)((pb_) + (d_) * (32 * (s_) + 8 * i - 144)) * (DA * 2); \
            glds16((const GAS unsigned char*)(vb_ + vo_), (unsigned)__builtin_amdgcn_readfirstlane((int)(vbase + (buf_) * 4096 + i * 1024))); } } while (0)
    { ATT_GEOM(0, d0, qr0); ATT_DMAV(d0, P0 + qr0, 0, 0); ATT_DMAV(d0, P0 + qr0, 1, 1); ATT_LOADKQ(d0, P0 + qr0); }
#pragma unroll 1
    for (int idx = 0; idx < 6; ++idx) {
        ATT_GEOM(idx, d, qrel0);
        const int pb = P0 + qrel0;
        f32x4 st[10];
#pragma unroll
        for (int kt = 1; kt < 10; ++kt) {
            const f32x4 a = MFMA16(kf[2 * kt - 2], qf0, ((f32x4){0.f, 0.f, 0.f, 0.f}));
            st[kt] = MFMA16(kf[2 * kt - 1], qf1, a);
        }
        const float NEG = -INFINITY;
#pragma unroll
        for (int r = 0; r < 4; ++r) { const int rk = 4 * g + r; if (rk < q16) st[1][r] = NEG; if (rk > q16) st[9][r] = NEG; }
        if (pb < 128 * d) {
#pragma unroll
            for (int kt = 1; kt < 10; ++kt)
#pragma unroll
                for (int r = 0; r < 4; ++r) if (pb + d * (16 * kt + 4 * g + r - 144) < 0) st[kt][r] = NEG;
        }
        float mx = NEG;
#pragma unroll
        for (int kt = 1; kt < 10; ++kt) mx = fmaxf(fmaxf(fmaxf(st[kt][0], st[kt][1]), fmaxf(st[kt][2], st[kt][3])), mx);
        mx = fmaxf(mx, __shfl_xor(mx, 16)); mx = fmaxf(mx, __shfl_xor(mx, 32));
        float ls = 0.f;
#pragma unroll
        for (int kt = 1; kt < 10; ++kt)
#pragma unroll
            for (int r = 0; r < 4; ++r) { const float e = __builtin_amdgcn_exp2f(st[kt][r] - mx); st[kt][r] = e; ls += e; }
        ls += __shfl_xor(ls, 16); ls += __shfl_xor(ls, 32);
        v4u pw[5];
        pw[0].x = 0u; pw[0].y = 0u; pw[0].z = cvtpk(st[1][0], st[1][1]); pw[0].w = cvtpk(st[1][2], st[1][3]);
#pragma unroll
        for (int s = 1; s < 5; ++s) { pw[s].x = cvtpk(st[2 * s][0], st[2 * s][1]); pw[s].y = cvtpk(st[2 * s][2], st[2 * s][3]); pw[s].z = cvtpk(st[2 * s + 1][0], st[2 * s + 1][1]); pw[s].w = cvtpk(st[2 * s + 1][2], st[2 * s + 1][3]); }
        __builtin_amdgcn_sched_barrier(0);
        ATT_WAITV(0);
        ATT_GEOM(idx + 1, dn, qrn);
        const int pbn = P0 + qrn;
        if (idx < 5) { ATT_LOADKQ(dn, pbn); }
        __builtin_amdgcn_sched_barrier(0);
        f32x4 o[4];
#pragma unroll
        for (int n = 0; n < 4; ++n) o[n] = (f32x4){0.f, 0.f, 0.f, 0.f};
#pragma unroll
        for (int s = 0; s < 5; ++s) {
            if (s == 2 || s == 3) ATT_WAITV(4);
            else if (s == 4) { ATT_WAITV(0);
#pragma unroll
                for (int i = 0; i < 18; ++i) asm volatile("" :: "v"(kf[i]));
                asm volatile("" :: "v"(qf0), "v"(qf1)); }
            const bf16x8 pf = __builtin_bit_cast(bf16x8, pw[s]);
            LAS unsigned char* vb = VB + (s & 1) * 4096;
            s16x4 lo[4], hi[4];
#pragma unroll
            for (int n = 0; n < 4; ++n) { lo[n] = ldtr(vb + tro[n]); hi[n] = ldtr(vb + tro[n] + 2048); }
            __builtin_amdgcn_sched_barrier(0);
#pragma unroll
            for (int n = 0; n < 4; ++n) {
                const bf16x8 vf = (bf16x8){lo[n][0], lo[n][1], lo[n][2], lo[n][3], hi[n][0], hi[n][1], hi[n][2], hi[n][3]};
                o[n] = MFMA16(pf, vf, o[n]);
            }
            asm volatile("s_waitcnt lgkmcnt(0)" ::: "memory");
            if (s < 3) { ATT_DMAV(d, pb, s + 2, s & 1); }
            else if (s == 4 && idx < 5) { ATT_DMAV(dn, pbn, 0, 0); ATT_DMAV(dn, pbn, 1, 1); }
            __builtin_amdgcn_sched_barrier(0);
        }
        const int p = idx >> 1;
#pragma unroll
        for (int r = 0; r < 4; ++r) {
            const int rho = 4 * g + r;
            const float mp = __shfl(mx, rho), lp = __shfl(ls, rho);
            const int qrel = qrel0 + d * rho;
            LAS float* arow = ACC + qrel * ACC_STRIDE + q16;
            if (p == 0) {
#pragma unroll
                for (int n = 0; n < 4; ++n) arow[16 * n] = o[n][r];
                if (q16 == 0) { ML[2 * qrel] = mp; ML[2 * qrel + 1] = lp; }
            } else {
                const float mo = ML[2 * qrel], lo_ = ML[2 * qrel + 1];
                const float mn = fmaxf(mo, mp), ao = __builtin_amdgcn_exp2f(mo - mn), ap = __builtin_amdgcn_exp2f(mp - mn), ln = lo_ * ao + lp * ap;
                if (p == 1) {
#pragma unroll
                    for (int n = 0; n < 4; ++n) arow[16 * n] = arow[16 * n] * ao + o[n][r] * ap;
                    if (q16 == 0) { ML[2 * qrel] = mn; ML[2 * qrel + 1] = ln; }
                } else {
                    const float inv = 1.0f / ln;
#pragma unroll
                    for (int n = 0; n < 4; ++n) arow[16 * n] = (arow[16 * n] * ao + o[n][r] * ap) * inv;
                }
            }
        }
        if (idx & 1) asm volatile("s_waitcnt lgkmcnt(0)\n\ts_barrier" ::: "memory");
    }
#undef ATT_GEOM
#undef ATT_LOADKQ
#undef ATT_DMAV
#pragma unroll
    for (int i = 0; i < 4; ++i) {
        const int idx = F.tid + 512 * i, qrel = idx >> 3, c8 = idx & 7;
        const LAS float* ar = ACC + qrel * ACC_STRIDE + 8 * c8;
        const f32x4 a0 = *(const LAS f32x4*)ar, a1 = *(const LAS f32x4*)(ar + 4);
        const v4u gw = *(const v4u*)(T.GA + (size_t)(P0 + qrel) * DA + h * HDIM + 8 * c8);
        v4u o; o.x = cvtpk(a0[0] * bflo(gw.x), a0[1] * bfhi(gw.x)); o.y = cvtpk(a0[2] * bflo(gw.y), a0[3] * bfhi(gw.y));
        o.z = cvtpk(a1[0] * bflo(gw.z), a1[1] * bfhi(gw.z)); o.w = cvtpk(a1[2] * bflo(gw.w), a1[3] * bfhi(gw.w));
        *(v4u*)(T.AC + (size_t)(P0 + qrel) * DM + h * HDIM + 8 * c8) = o;
    }
    __syncthreads();
}

__device__ __forceinline__ void gmlp_item(const Frame& F, const P2Ptrs& T, int ck, int gi) {
    const int lane = F.lane, w = F.wave, q16 = lane & 15, g = lane >> 4, tid = F.tid;
    LAS unsigned char* IMG = F.lds;
    LAS f32x2v* RS = (LAS f32x2v*)(F.lds + 32768);
    LAS float* OUTB = (LAS float*)(F.lds + 36864);
    const int r0 = ck * 128, ch0 = gi * 128;
    const int c8 = tid & 15, s0 = tid >> 4;
    v4u gvr[4];
#pragma unroll
    for (int i = 0; i < 4; ++i) gvr[i] = *(const GAS v4u*)(T.GV + (size_t)(r0 + s0 + 32 * i) * DA + ch0 + 8 * c8);
    const f32x4 lg0 = *(const GAS f32x4*)(T.ln_g + ch0 + 8 * c8), lg1 = *(const GAS f32x4*)(T.ln_g + ch0 + 8 * c8 + 4);
    const f32x4 lb0 = *(const GAS f32x4*)(T.ln_b + ch0 + 8 * c8), lb1 = *(const GAS f32x4*)(T.ln_b + ch0 + 8 * c8 + 4);
    if (tid < 128) {
        const GAS float* sp = (const GAS float*)T.stats + (size_t)(r0 + tid) * 32; float s1 = 0.f, s2 = 0.f;
#pragma unroll
        for (int i = 0; i < 8; ++i) { const f32x4 v = *(const GAS f32x4*)(sp + 4 * i); s1 += v[0] + v[2]; s2 += v[1] + v[3]; }
        const float mu = s1 * (1.0f / DA), var = fmaxf(s2 * (1.0f / DA) - mu * mu, 0.f);
        f32x2v o; o.x = mu; o.y = 1.0f / sqrtf(var + EPS); RS[tid] = o;
    }
    bf16x8 af[20];
    {
        const GAS bf16* wm = (const GAS bf16*)T.WMP + (size_t)gi * 128 * 128 + (size_t)q16 * 128 + 8 * g;
        int k = 0;
#pragma unroll
        for (int tt = 0; tt < 8; ++tt)
#pragma unroll
            for (int ss = 0; ss < 4; ++ss) if (ss <= (tt >> 1)) { af[k] = *(const GAS bf16x8*)(wm + (size_t)tt * 16 * 128 + 32 * ss); ++k; }
    }
    __syncthreads();
#pragma unroll
    for (int i = 0; i < 4; ++i) {
        const int s = s0 + 32 * i;
        const f32x2v ms = RS[s];
        const v4u gv = gvr[i];
        v4u o;
        o.x = cvtpk((bflo(gv.x) - ms.x) * ms.y * lg0[0] + lb0[0], (bfhi(gv.x) - ms.x) * ms.y * lg0[1] + lb0[1]);
        o.y = cvtpk((bflo(gv.y) - ms.x) * ms.y * lg0[2] + lb0[2], (bfhi(gv.y) - ms.x) * ms.y * lg0[3] + lb0[3]);
        o.z = cvtpk((bflo(gv.z) - ms.x) * ms.y * lg1[0] + lb1[0], (bfhi(gv.z) - ms.x) * ms.y * lg1[1] + lb1[1]);
        o.w = cvtpk((bflo(gv.w) - ms.x) * ms.y * lg1[2] + lb1[2], (bfhi(gv.w) - ms.x) * ms.y * lg1[3] + lb1[3]);
        *(LAS v4u*)(IMG + (c8 >> 1) * 4096 + s * 32 + (c8 & 1) * 16) = o;
    }
    v4u ur[4], gbr[4]; float bs[4];
#pragma unroll
    for (int i = 0; i < 4; ++i) {
        const size_t row = (size_t)(r0 + s0 + 32 * i);
        ur[i] = *(const GAS v4u*)(T.U + row * DA + ch0 + 8 * c8); gbr[i] = *(const GAS v4u*)(T.GB + row * DA + ch0 + 8 * c8);
        bs[i] = *((const GAS float*)T.b_s + gi * 128 + s0 + 32 * i);
    }
    __syncthreads();
    {
        bf16x8 bfr[4];
        const int troff = w * 4096 + (4 * g + (q16 >> 2)) * 32 + (q16 & 3) * 8;
#pragma unroll
        for (int ss = 0; ss < 4; ++ss) {
            const s16x4 lo = ldtr(IMG + troff + ss * 1024), hi = ldtr(IMG + troff + ss * 1024 + 512);
            bfr[ss] = (bf16x8){lo[0], lo[1], lo[2], lo[3], hi[0], hi[1], hi[2], hi[3]};
        }
        int k = 0;
#pragma unroll
        for (int tt = 0; tt < 8; ++tt) {
            f32x4 acc = (f32x4){0.f, 0.f, 0.f, 0.f};
#pragma unroll
            for (int ss = 0; ss < 4; ++ss) if (ss <= (tt >> 1)) { acc = MFMA16(af[k], bfr[ss], acc); ++k; }
#pragma unroll
            for (int r = 0; r < 4; ++r) OUTB[(16 * tt + 4 * g + r) * 132 + 16 * w + q16] = acc[r];
        }
    }
    __syncthreads();
#pragma unroll
    for (int i = 0; i < 4; ++i) {
        const int t = s0 + 32 * i;
        const LAS float* ob = OUTB + t * 132 + 8 * c8;
        const f32x4 m0 = *(const LAS f32x4*)ob + bs[i], m1 = *(const LAS f32x4*)(ob + 4) + bs[i];
        const v4u uv = ur[i], gb = gbr[i];
        v4u o;
        o.x = cvtpk(bflo(uv.x) * m0[0] * bflo(gb.x), bfhi(uv.x) * m0[1] * bfhi(gb.x)); o.y = cvtpk(bflo(uv.y) * m0[2] * bflo(gb.y), bfhi(uv.y) * m0[3] * bfhi(gb.y));
        o.z = cvtpk(bflo(uv.z) * m1[0] * bflo(gb.z), bfhi(uv.z) * m1[1] * bfhi(gb.z)); o.w = cvtpk(bflo(uv.w) * m1[2] * bflo(gb.w), bfhi(uv.w) * m1[3] * bfhi(gb.w));
        *(GAS v4u*)(T.AC + (size_t)(r0 + t) * DM + DA + ch0 + 8 * c8) = o;
    }
    __syncthreads();
}

__device__ __forceinline__ void sattn_item(const Frame& F, const P2Ptrs& T, int si) {
    const int lane = F.lane, w = F.wave, kk = lane >> 2, part = lane & 3;
    const int b = si >> 6, h = (si >> 2) & 15, t = si & 3;
    LAS float* SC = (LAS float*)(F.lds + w * 2048);
    const float* qp = T.qs + (size_t)(b * 4 + t) * DA + h * HDIM + 4 * part;
    f32x4 qv[4];
#pragma unroll
    for (int i = 0; i < 4; ++i) qv[i] = *(const f32x4*)(qp + 16 * i);
    float mx = -INFINITY;
#pragma unroll 1
    for (int p = 0; p < 3; ++p) {
        const int d = p == 0 ? 1 : (p == 1 ? 4 : 16);
#pragma unroll 3
        for (int ps = 0; ps < 9; ++ps) {
            const int j = ps * 16 + kk, jj = j > 128 ? 128 : j, idx = WBUF + t - jj * d;
            const float* kr = idx >= WBUF ? T.ksn + ((size_t)(b * 4 + idx - WBUF) * NHEAD + h) * HDIM : T.ck + ((size_t)(b * WBUF + idx) * NHEAD + h) * HDIM;
            kr += 4 * part;
            float s = 0.f;
#pragma unroll
            for (int i = 0; i < 4; ++i) { const f32x4 kv = *(const f32x4*)(kr + 16 * i); s += (qv[i][0] * kv[0] + qv[i][1] * kv[1]) + (qv[i][2] * kv[2] + qv[i][3] * kv[3]); }
            s += __shfl_xor(s, 1); s += __shfl_xor(s, 2);
            if (j > 128) s = -INFINITY;
            if (part == 0) SC[p * 144 + ps * 16 + kk] = s;
            mx = fmaxf(mx, s);
        }
    }
    mx = fmaxf(mx, __shfl_xor(mx, 4)); mx = fmaxf(mx, __shfl_xor(mx, 8)); mx = fmaxf(mx, __shfl_xor(mx, 16)); mx = fmaxf(mx, __shfl_xor(mx, 32));
    f32x4 o[4]; float ls = 0.f;
#pragma unroll
    for (int i = 0; i < 4; ++i) o[i] = (f32x4){0.f, 0.f, 0.f, 0.f};
#pragma unroll 1
    for (int p = 0; p < 3; ++p) {
        const int d = p == 0 ? 1 : (p == 1 ? 4 : 16);
#pragma unroll 3
        for (int ps = 0; ps < 9; ++ps) {
            const int j = ps * 16 + kk, jj = j > 128 ? 128 : j, idx = WBUF + t - jj * d;
            const float* vr = idx >= WBUF ? T.vsn + ((size_t)(b * 4 + idx - WBUF) * NHEAD + h) * HDIM : T.cv + ((size_t)(b * WBUF + idx) * NHEAD + h) * HDIM;
            vr += 4 * part;
            const float pe = __builtin_amdgcn_exp2f(SC[p * 144 + ps * 16 + kk] - mx);
            ls += pe;
#pragma unroll
            for (int i = 0; i < 4; ++i) { const f32x4 vv = *(const f32x4*)(vr + 16 * i); o[i] += vv * pe; }
        }
    }
#pragma unroll
    for (int sh = 4; sh < 64; sh <<= 1) {
        ls += __shfl_xor(ls, sh);
#pragma unroll
        for (int i = 0; i < 4; ++i)
#pragma unroll
            for (int e = 0; e < 4; ++e) o[i][e] += __shfl_xor(o[i][e], sh);
    }
    if (kk == 0) {
        const float inv = 1.0f / ls;
        const size_t row = (size_t)(SEQ + b * 4 + t);
#pragma unroll
        for (int i = 0; i < 4; ++i) {
            const int c = h * HDIM + 16 * i + 4 * part;
            const u32x2v gw = *(const u32x2v*)(T.GA + row * DA + c);
            u32x2v ov; ov.x = cvtpk(o[i][0] * inv * bflo(gw.x), o[i][1] * inv * bfhi(gw.x)); ov.y = cvtpk(o[i][2] * inv * bflo(gw.y), o[i][3] * inv * bfhi(gw.y));
            *(u32x2v*)(T.AC + row * DM + c) = ov;
        }
    }
}

__device__ __forceinline__ void sgmlp_item(const Frame& F, const P2Ptrs& T, int b) {
    const int lane = F.lane;
    float mu[4], rs[4];
    {
        const f32x2v pr = *(const f32x2v*)(T.stats + ((size_t)(SEQ + b * 4 + (lane >> 4)) * 16 + (lane & 15)) * 2);
        float s1 = pr.x, s2 = pr.y;
#pragma unroll
        for (int o = 1; o < 16; o <<= 1) { s1 += __shfl_xor(s1, o); s2 += __shfl_xor(s2, o); }
        const float m_ = s1 * (1.0f / DA), var = fmaxf(s2 * (1.0f / DA) - m_ * m_, 0.f), r_ = 1.0f / sqrtf(var + EPS);
#pragma unroll
        for (int t = 0; t < 4; ++t) { mu[t] = __shfl(m_, 16 * t); rs[t] = __shfl(r_, 16 * t); }
    }
#pragma unroll 1
    for (int hh = 0; hh < 2; ++hh) {
        const int ch = hh * 512 + lane * 8, gi = ch >> 7;
        float lg[8], lb[8];
#pragma unroll
        for (int e = 0; e < 8; ++e) { lg[e] = T.ln_g[ch + e]; lb[e] = T.ln_b[ch + e]; }
        float vn[4][8];
#pragma unroll
        for (int t = 0; t < 4; ++t) {
            const size_t row = (size_t)(SEQ + b * 4 + t);
            const v4u gv = *(const v4u*)(T.GV + row * DA + ch);
            const unsigned wv[4] = {gv.x, gv.y, gv.z, gv.w};
#pragma unroll
            for (int e = 0; e < 4; ++e) { vn[t][2 * e] = (bflo(wv[e]) - mu[t]) * rs[t] * lg[2 * e] + lb[2 * e]; vn[t][2 * e + 1] = (bfhi(wv[e]) - mu[t]) * rs[t] * lg[2 * e + 1] + lb[2 * e + 1]; }
            float* vo = T.vc_out + (size_t)(b * 4 + t) * DA + ch;
            *(f32x4*)vo = (f32x4){vn[t][0], vn[t][1], vn[t][2], vn[t][3]}; *(f32x4*)(vo + 4) = (f32x4){vn[t][4], vn[t][5], vn[t][6], vn[t][7]};
        }
#pragma unroll
        for (int t = 0; t < 4; ++t) {
            const size_t row = (size_t)(SEQ + b * 4 + t);
            float mix[8];
            const float bias = T.b_s[gi * 128 + t];
#pragma unroll
            for (int e = 0; e < 8; ++e) mix[e] = bias;
#pragma unroll
            for (int s = 0; s < 4; ++s) if (s <= t) { const float wts = T.w_s[(size_t)(gi * 128 + t) * 128 + s];
#pragma unroll
                for (int e = 0; e < 8; ++e) mix[e] += wts * vn[s][e]; }
            const v4u uv = *(const v4u*)(T.U + row * DA + ch), gb = *(const v4u*)(T.GB + row * DA + ch);
            v4u o;
            o.x = cvtpk(bflo(uv.x) * mix[0] * bflo(gb.x), bfhi(uv.x) * mix[1] * bfhi(gb.x)); o.y = cvtpk(bflo(uv.y) * mix[2] * bflo(gb.y), bfhi(uv.y) * mix[3] * bfhi(gb.y));
            o.z = cvtpk(bflo(uv.z) * mix[4] * bflo(gb.z), bfhi(uv.z) * mix[5] * bfhi(gb.z)); o.w = cvtpk(bflo(uv.w) * mix[6] * bflo(gb.w), bfhi(uv.w) * mix[7] * bfhi(gb.w));
            *(v4u*)(T.AC + row * DM + DA + ch) = o;
        }
    }
}


__device__ __forceinline__ void sout_item(const Frame& F, const bf16* AC, const bf16* WoT, const float* xs, float* out, float* ssq, int rt, int ct) {
    const int lane = F.lane, w = F.wave, q16 = lane & 15, g = lane >> 4, tid = F.tid;
    LAS float* RED = (LAS float*)F.lds;
    const GAS unsigned char* ab = (const GAS unsigned char*)(AC + (size_t)(SEQ + 16 * rt + q16) * DM + 256 * w + 8 * g);
    const GAS unsigned char* bb = (const GAS unsigned char*)(WoT + (size_t)(64 * ct + q16) * DM + 256 * w + 8 * g);
    bf16x8 af[8];
#pragma unroll
    for (int ks = 0; ks < 8; ++ks) af[ks] = *(const GAS bf16x8*)(ab + 64 * ks);
    f32x4 acc[4];
#pragma unroll
    for (int nb = 0; nb < 4; ++nb) {
        bf16x8 bf_[8];
#pragma unroll
        for (int ks = 0; ks < 8; ++ks) bf_[ks] = *(const GAS bf16x8*)(bb + (size_t)nb * 16 * DM * 2 + 64 * ks);
        f32x4 a = (f32x4){0.f, 0.f, 0.f, 0.f};
#pragma unroll
        for (int ks = 0; ks < 8; ++ks) a = MFMA16(af[ks], bf_[ks], a);
        acc[nb] = a;
    }
#pragma unroll
    for (int nb = 0; nb < 4; ++nb)
#pragma unroll
        for (int r = 0; r < 4; ++r) RED[(w * 16 + 4 * g + r) * 64 + 16 * nb + q16] = acc[nb][r];
    __syncthreads();
    {
        const int row = tid >> 5, c2 = (tid & 31) * 2;
        float s0 = 0.f, s1 = 0.f;
#pragma unroll
        for (int ww = 0; ww < 8; ++ww) { const f32x2v v = *(const LAS f32x2v*)(RED + (ww * 16 + row) * 64 + c2); s0 += v.x; s1 += v.y; }
        const size_t grow = (size_t)(SEQ + 16 * rt + row);
        const f32x2v xr = *(const f32x2v*)(xs + (size_t)(16 * rt + row) * DM + 64 * ct + c2);
        f32x2v y; y.x = xr.x + s0; y.y = xr.y + s1;
        *(f32x2v*)(out + grow * DM + 64 * ct + c2) = y;
        float ss = y.x * y.x + y.y * y.y;
#pragma unroll
        for (int o = 1; o < 32; o <<= 1) ss += __shfl_xor(ss, o);
        if ((tid & 31) == 0) ssq[grow * 32 + ct] = ss;
    }
    __syncthreads();
}

__device__ __forceinline__ void p2_mixers(const Frame& F, const P2Ptrs& T) {
    for (int it = F.vcu; it < 512 * REP_ATT; it += F.G) attn_item(F, T, (it & 511) >> 5, (it & 31) * 256);
    for (int it = F.vcu; it < 512; it += F.G) gmlp_item(F, T, it >> 3, it & 7);
#if REP_GMLP > 1
    for (int it = F.vcu; it < 512; it += F.G) gmlp_item(F, T, it >> 3, it & 7);
#endif
    const int gw = F.vcu * NWAVES + F.wave, NGW = F.G * NWAVES;
    for (int si = gw; si < 2048; si += NGW) sattn_item(F, T, si);
#if REP_SATT > 1
    for (int si = gw; si < 2048; si += NGW) sattn_item(F, T, si);
#endif
    for (int b = gw; b < 32; b += NGW) sgmlp_item(F, T, b);
}

__device__ __forceinline__ void p4_final(const Frame& F, const float* yin, float* out, const float* ssq, const float* fg) {
    const int gw = F.vcu * NWAVES + F.wave, NGW = F.G * NWAVES, lane = F.lane;
    f32x4 gv[8];
#pragma unroll
    for (int j = 0; j < 8; ++j) gv[j] = *((const f32x4*)fg + 64 * j + lane);
    for (int m = gw; m < MROWS; m += NGW) {
        float s = lane < 32 ? ssq[(size_t)m * 32 + lane] : 0.f;
        s = wave_sum(s);
        const float r = 1.0f / sqrtf(s * (1.0f / DM) + EPS);
        const f32x4* yi = (const f32x4*)(yin + (size_t)m * DM) + lane; f32x4* yr = (f32x4*)(out + (size_t)m * DM) + lane;
#pragma unroll
        for (int j = 0; j < 8; ++j) { const f32x4 v = yi[64 * j]; yr[64 * j] = v * r * gv[j]; }
    }
}


__global__ void __launch_bounds__(NWAVES * 64, 2) hybrid_fwd(Args args) {
    extern __shared__ __attribute__((aligned(16))) unsigned char lds[];
    Frame F;
    F.lds = (LAS unsigned char*)lds;
    F.tid = threadIdx.x; F.lane = F.tid & 63; F.wave = __builtin_amdgcn_readfirstlane(F.tid >> 6);
    F.G = gridDim.x; { const int bx = blockIdx.x; F.vcu = (F.G % 8 == 0) ? (bx % 8) * (F.G / 8) + bx / 8 : bx; }
    unsigned char* ws = args.ws;
#ifdef Y_BUF
    float* const YPRE = (float*)(ws + WS_Y);
#else
    float* const YPRE = args.out;
#endif
    volatile LAS unsigned* MISC = (volatile LAS unsigned*)(F.lds + MISC_OFF);
    if (F.tid < 64) MISC[F.tid] = 0u;
    __syncthreads();
    XcdBarrier bar = xcd_barrier_post((unsigned*)(ws + WS_CTL) + CW_BAR, MISC + 8);

#ifndef SKIP_P0
    p0_prologue(F, args);
#endif
#if REP_P0 > 1
    p0_prologue(F, args);
#endif
    xcd_barrier(bar);
#if REP_BAR > 1
    xcd_barrier(bar);
#endif

#ifndef SKIP_P1
    for (int rep = 0; rep < REP_P1; ++rep) {
        pg8::Gemm g{(const pg8::bf16_t*)(ws + WS_XN), (const pg8::bf16_t*)(ws + WS_WIN), MP, DIN, DM};
        pg8::StaticOrder S; S.init(MP, DIN, F.G, (int)blockIdx.x);
        EpiIn E{(bf16*)(ws + WS_Q), (bf16*)(ws + WS_K) + (size_t)PADR * DA, (bf16*)(ws + WS_V) + (size_t)PADR * DA, (bf16*)(ws + WS_GA), (bf16*)(ws + WS_U), (bf16*)(ws + WS_GV), (bf16*)(ws + WS_GB),
                (const float*)(ws + WS_ROPE), (float*)(ws + WS_STATS), args.out, (float*)(ws + WS_QS)};
        pg8::gemm_phase<EpiIn, pg8::StaticOrder, true, true>(F.lds, g, S, E);
    }
    xcd_barrier(bar);
#if REP_BAR > 1
    xcd_barrier(bar);
#endif

#endif
#ifndef SKIP_P2
    {
        P2Ptrs T{(const bf16*)(ws + WS_Q), (const bf16*)(ws + WS_K), (const bf16*)(ws + WS_V), (const bf16*)(ws + WS_GA), (const bf16*)(ws + WS_U), (const bf16*)(ws + WS_GV), (const bf16*)(ws + WS_GB),
                 (const bf16*)(ws + WS_WMP), (const float*)(ws + WS_STATS), (bf16*)(ws + WS_AC), args.in[2], args.in[3], args.out + OFF_KS, args.out + OFF_VS, (const float*)(ws + WS_QS),
                 args.in[6], args.in[7], args.in[8], args.in[9], args.out + OFF_VC};
        p2_mixers(F, T);
    }
    xcd_barrier(bar);
#if REP_BAR > 1
    xcd_barrier(bar);
#endif

#endif
#ifndef SKIP_P3
    for (int it = F.vcu; it < 256; it += F.G) sout_item(F, (const bf16*)(ws + WS_AC), (const bf16*)(ws + WS_WOUT), args.in[1], YPRE, (float*)(ws + WS_SS), it >> 5, it & 31);
    for (int rep = 0; rep < REP_P3; ++rep) {
        pg8::Gemm g{(const pg8::bf16_t*)(ws + WS_AC), (const pg8::bf16_t*)(ws + WS_WOUT), SEQ, DM, DM};
        pg8::StaticOrder S; S.init(SEQ, DM, F.G, (int)blockIdx.x);
        EpiOut E{args.in[0], args.in[1], YPRE, (float*)(ws + WS_SS)};
        pg8::gemm_phase<EpiOut, pg8::StaticOrder, true, true>(F.lds, g, S, E);
    }
    xcd_barrier(bar);
#if REP_BAR > 1
    xcd_barrier(bar);
#endif

#endif
    p4_final(F, YPRE, args.out, (const float*)(ws + WS_SS), args.in[11]);
#if REP_P4 > 1
    p4_final(F, YPRE, args.out, (const float*)(ws + WS_SS), args.in[11]);
#endif
}

extern "C" void kernel_launch(void* const* d_in, const int* in_sizes, int n_in, void* d_out, int out_size, void* d_ws, size_t ws_size, hipStream_t stream) {
    static int grid = 0;
    if (grid == 0) {
        if (n_in != 12 || out_size != (int)OUT_TOTAL || ws_size < WS_END) { fprintf(stderr, "kernel_launch: unexpected shapes (n_in %d out %d ws %zu)\n", n_in, out_size, ws_size); grid = -1; return; }
        int dev = 0, cus = 0, per_cu = 0;
        if (hipGetDevice(&dev) != hipSuccess || hipDeviceGetAttribute(&cus, hipDeviceAttributeMultiprocessorCount, dev) != hipSuccess) { grid = -1; return; }
        if (hipFuncSetAttribute((const void*)hybrid_fwd, hipFuncAttributeMaxDynamicSharedMemorySize, LDS_BYTES) != hipSuccess) { fprintf(stderr, "kernel_launch: hipFuncSetAttribute failed\n"); grid = -1; return; }
        if (hipOccupancyMaxActiveBlocksPerMultiprocessor(&per_cu, (const void*)hybrid_fwd, NWAVES * 64, LDS_BYTES) != hipSuccess || per_cu < 1) { fprintf(stderr, "kernel_launch: occupancy query reports %d blocks per CU\n", per_cu); (void)hipGetLastError(); grid = -1; return; }
        grid = cus;
    }
    if (grid < 0) return;
    if (hipMemsetAsync((char*)d_ws + WS_CTL, 0, CTL_ZERO_BYTES, stream) != hipSuccess) return;
    Args a{};
    for (int i = 0; i < 12; ++i) a.in[i] = (const float*)d_in[i];
    a.out = (float*)d_out; a.ws = (unsigned char*)d_ws;
    for (int i = 0; i < 32; ++i) a.invf[i] = exp(-log(10000.0) * (double)i / 32.0);
    hipLaunchKernelGGL(hybrid_fwd, dim3(grid), dim3(NWAVES * 64), LDS_BYTES, stream, a);
}
```

```cpp
#include <hip/hip_runtime.h>
#include <cstdio>
#include <cstdint>
#include <cmath>

namespace pg8 {
#define PG8_LAS __attribute__((address_space(3)))
typedef unsigned short bf16_t;
typedef short bf16x8 __attribute__((ext_vector_type(8)));
typedef float f32x4 __attribute__((ext_vector_type(4)));
typedef unsigned u32x4 __attribute__((ext_vector_type(4)));
constexpr int BM = 256, BK = 64, HALF = 128, HTB = HALF * BK * 2  , STAGE_BYTES = 8 * HTB, NXCD = 8, WGM = 8;

__host__ __device__ __forceinline__ int lds_byte(int r, int c) { const int st = (r >> 4) * 2 + (c >> 5), rr = r & 15, cc = c & 31, ob = rr * 64 + cc * 2; return st * 1024 + (ob ^ (((ob >> 9) & 1) << 5)); }
__host__ __device__ __forceinline__ void stage_rc(int b, int& R, int& C) { const int st = b / 1024, sb = b % 1024, swz = sb ^ (((sb >> 9) & 1) << 5); R = (st >> 1) * 16 + swz / 64; C = (st & 1) * 32 + (swz % 64) / 2; }
__host__ __device__ __forceinline__ int perm32(int rho) { const int n = rho >> 4, i = rho & 15; return 8 * (i >> 2) + 4 * n + (i & 3); }

struct Unit { int pm, pn; };
struct Gemm { const bf16_t* A; const bf16_t* Bt; int M, N, K; };

struct StaticOrder {
    int nM, nN, nwg, G, c;
    __host__ __device__ void init(int M, int N, int G_, int c_) { nM = M / BM; nN = N / BM; nwg = nM * nN; G = G_; c = c_; }
    __host__ __device__ bool next(int i, Unit& u) const {
        const long L = (long)i * G + c; if (L >= nwg) return false;
        int wgid = (int)L; { const int q = nwg / NXCD, r = nwg % NXCD, xcd = wgid % NXCD, off = wgid / NXCD; wgid = (xcd < r ? xcd * (q + 1) : r * (q + 1) + (xcd - r) * q) + off; }
        const int nig = WGM * nN, gid = wgid / nig, fm = gid * WGM, gsz = (nM - fm) < WGM ? (nM - fm) : WGM;
        u.pm = fm + ((wgid % nig) % gsz); u.pn = (wgid % nig) / gsz; return true;
    }
    __device__ __forceinline__ void a_ready(const Unit&) const {}
    __device__ __forceinline__ void done(const Unit&) const {}
};
__device__ __forceinline__ unsigned cvt_pk_bf16(float lo, float hi) { unsigned r; asm volatile("v_cvt_pk_bf16_f32 %0, %1, %2" : "=v"(r) : "v"(lo), "v"(hi)); return r; }
template <class Epi, class Sched, bool ALIGN_EPI = false, bool SP2 = false>
__device__ __forceinline__ void gemm_phase(PG8_LAS unsigned char* lds, const Gemm g, const Sched& S, const Epi& E) {
    const int tid = threadIdx.x, wid = __builtin_amdgcn_readfirstlane(tid >> 6), lane = tid & 63, wr = wid >> 2, wc = wid & 3, fr = lane & 15, fq = lane >> 4;
    const int K = g.K, nt = K / BK;
    unsigned voffA[2], voffB[2];
#pragma unroll
    for (int i = 0; i < 2; ++i) { int R, C; stage_rc(tid * 16 + i * 8192, R, C); const int Rb = Epi::PERM ? ((R & ~31) + perm32(R & 31)) : R;
        voffA[i] = (unsigned)(R * K + C) * 2u; voffB[i] = (unsigned)(Rb * K + C) * 2u; }
    const size_t kstep = (size_t)(BK * 2);
    const size_t hstep = (size_t)HALF * K * 2;
    const size_t tstep = 2 * hstep;
    const unsigned ldsw = (unsigned)wid * 1024u;
    const int aoff = lds_byte(wr * 64 + fr, fq * 8), boff = lds_byte(wc * 32 + fr, fq * 8);
#define PG8_SA(b, h) (((b) * 2 + (h)) * HTB)
#define PG8_SB(b, h) ((4 + (b) * 2 + (h)) * HTB)
#define PG8_STAGE(bufoff, gbase, voff) do { _Pragma("unroll") for (int _i = 0; _i < 2; ++_i) \
        __builtin_amdgcn_global_load_lds((const unsigned*)((const char*)(gbase) + (voff)[_i]), (PG8_LAS unsigned*)(lds + (bufoff) + ldsw + _i * 8192), 16, 0, 0); } while (0)
#define PG8_LDA(dst, b, h) do { _Pragma("unroll") for (int m = 0; m < 4; ++m) _Pragma("unroll") for (int k = 0; k < 2; ++k) dst[m][k] = *(const PG8_LAS bf16x8*)(lds + PG8_SA(b, h) + aoff + m * 2048 + k * 1024); } while (0)
#define PG8_LDB(dst, b, h) do { _Pragma("unroll") for (int n = 0; n < 2; ++n) _Pragma("unroll") for (int k = 0; k < 2; ++k) dst[n][k] = *(const PG8_LAS bf16x8*)(lds + PG8_SB(b, h) + boff + n * 2048 + k * 1024); } while (0)
#define PG8_MMA(ai, bj, At, Bt) do { __builtin_amdgcn_s_setprio(1); _Pragma("unroll") for (int m = 0; m < 4; ++m) _Pragma("unroll") for (int n = 0; n < 2; ++n) _Pragma("unroll") for (int k = 0; k < 2; ++k) \
        acc[ai][bj][m][n] = __builtin_amdgcn_mfma_f32_16x16x32_bf16(Bt[n][k], At[m][k], acc[ai][bj][m][n], 0, 0, 0); __builtin_amdgcn_s_setprio(0); } while (0)
#define PG8_WAIT_V(n) asm volatile("s_waitcnt vmcnt(" #n ")" ::: "memory")
#define PG8_WAIT_L(n) asm volatile("s_waitcnt lgkmcnt(" #n ")" ::: "memory")
#define PG8_BAR __builtin_amdgcn_s_barrier()
#define PG8_SCHED __builtin_amdgcn_sched_barrier(0)
    Unit cur, nxt; int ui = 0;
    if (!S.next(0, cur)) return;
    f32x4 acc[2][2][4][2];
#pragma unroll
    for (int a = 0; a < 2; ++a)
#pragma unroll
        for (int b = 0; b < 2; ++b)
#pragma unroll
            for (int m = 0; m < 4; ++m)
#pragma unroll
                for (int n = 0; n < 2; ++n) acc[a][b][m][n] = (f32x4){0.f, 0.f, 0.f, 0.f};
    bf16x8 At[4][2], B0[2][2], B1[2][2];
    const char* cA = (const char*)g.A + (size_t)cur.pm * tstep; const char* cB = (const char*)g.Bt + (size_t)cur.pn * tstep;
    S.a_ready(cur);
    if constexpr (SP2) {
        PG8_STAGE(PG8_SB(0, 0), cB, voffB); PG8_STAGE(PG8_SB(0, 1), cB + hstep, voffB); PG8_STAGE(PG8_SA(0, 0), cA, voffA); PG8_STAGE(PG8_SA(0, 1), cA + hstep, voffA);
        if (wr == 1) PG8_BAR;
        PG8_WAIT_V(2); PG8_BAR;
        PG8_STAGE(PG8_SB(1, 0), cB + kstep, voffB); PG8_STAGE(PG8_SA(1, 0), cA + kstep, voffA); PG8_STAGE(PG8_SB(1, 1), cB + hstep + kstep, voffB);
        PG8_WAIT_V(6); PG8_BAR;
    } else {
        PG8_STAGE(PG8_SB(0, 0), cB, voffB); PG8_STAGE(PG8_SA(0, 0), cA, voffA); PG8_STAGE(PG8_SB(0, 1), cB + hstep, voffB); PG8_STAGE(PG8_SA(0, 1), cA + hstep, voffA);
        if (wr == 1) PG8_BAR;
        PG8_WAIT_V(4); PG8_BAR;
        PG8_STAGE(PG8_SB(1, 0), cB + kstep, voffB); PG8_STAGE(PG8_SA(1, 0), cA + kstep, voffA); PG8_STAGE(PG8_SB(1, 1), cB + hstep + kstep, voffB);
        PG8_WAIT_V(6); PG8_BAR;
    }
    for (;;) {
        const bool has_next = S.next(ui + 1, nxt);
        const char* nA = has_next ? (const char*)g.A + (size_t)nxt.pm * tstep : cA; const char* nB = has_next ? (const char*)g.Bt + (size_t)nxt.pn * tstep : cB;
        for (int t = 0; t < nt; t += 2) {
            const bool last = (t == nt - 2);
            const char* a1 = cA + (size_t)(t + 1) * kstep;
            const char* a2 = last ? nA : cA + (size_t)(t + 2) * kstep; const char* b2 = last ? nB : cB + (size_t)(t + 2) * kstep;
            const char* a3 = a2 + kstep; const char* b3 = b2 + kstep;
            if (last && has_next) S.a_ready(nxt);
            if constexpr (SP2) {
            PG8_LDB(B0, 0, 0); PG8_LDB(B1, 0, 1); PG8_SCHED; PG8_LDA(At, 0, 0); PG8_STAGE(PG8_SA(1, 1), a1 + hstep, voffA);
            PG8_WAIT_V(8); PG8_WAIT_L(0); PG8_BAR; PG8_MMA(0, 0, At, B0); PG8_MMA(0, 1, At, B1); PG8_BAR; PG8_SCHED;
            PG8_LDA(At, 0, 1); PG8_STAGE(PG8_SB(0, 0), b2, voffB); PG8_STAGE(PG8_SB(0, 1), b2 + hstep, voffB); PG8_STAGE(PG8_SA(0, 0), a2, voffA);
            PG8_WAIT_V(8); PG8_WAIT_L(0); PG8_BAR; PG8_MMA(1, 0, At, B0); PG8_MMA(1, 1, At, B1); PG8_BAR; PG8_SCHED;
            PG8_LDB(B0, 1, 0); PG8_LDB(B1, 1, 1); PG8_SCHED; PG8_LDA(At, 1, 0); PG8_STAGE(PG8_SA(0, 1), a2 + hstep, voffA);
            PG8_WAIT_V(8); PG8_WAIT_L(0); PG8_BAR; PG8_MMA(0, 0, At, B0); PG8_MMA(0, 1, At, B1); PG8_BAR; PG8_SCHED;
            PG8_LDA(At, 1, 1); PG8_STAGE(PG8_SB(1, 0), b3, voffB); PG8_STAGE(PG8_SB(1, 1), b3 + hstep, voffB); PG8_STAGE(PG8_SA(1, 0), a3, voffA);
            PG8_WAIT_V(8); PG8_WAIT_L(0); PG8_BAR; PG8_MMA(1, 0, At, B0); PG8_MMA(1, 1, At, B1); PG8_BAR; PG8_SCHED;
            } else {
            PG8_LDB(B0, 0, 0); PG8_SCHED; PG8_LDA(At, 0, 0); PG8_STAGE(PG8_SA(1, 1), a1 + hstep, voffA);
            PG8_WAIT_L(8); PG8_BAR; PG8_WAIT_L(0); PG8_MMA(0, 0, At, B0); PG8_BAR; PG8_SCHED;
            PG8_LDB(B1, 0, 1); PG8_STAGE(PG8_SB(0, 0), b2, voffB);
            PG8_BAR; PG8_WAIT_L(0); PG8_MMA(0, 1, At, B1); PG8_BAR;
            PG8_LDA(At, 0, 1); PG8_STAGE(PG8_SA(0, 0), a2, voffA);
            PG8_BAR; PG8_WAIT_L(0); PG8_MMA(1, 0, At, B0); PG8_BAR; PG8_SCHED;
            PG8_STAGE(PG8_SB(0, 1), b2 + hstep, voffB);
            PG8_WAIT_V(6); PG8_BAR; PG8_MMA(1, 1, At, B1); PG8_BAR;
            PG8_LDB(B0, 1, 0); PG8_SCHED; PG8_LDA(At, 1, 0); PG8_STAGE(PG8_SA(0, 1), a2 + hstep, voffA);
            PG8_WAIT_L(8); PG8_BAR; PG8_WAIT_L(0); PG8_MMA(0, 0, At, B0); PG8_BAR; PG8_SCHED;
            PG8_LDB(B1, 1, 1); PG8_STAGE(PG8_SB(1, 0), b3, voffB);
            PG8_BAR; PG8_WAIT_L(0); PG8_MMA(0, 1, At, B1); PG8_BAR;
            PG8_LDA(At, 1, 1); PG8_STAGE(PG8_SA(1, 0), a3, voffA);
            PG8_BAR; PG8_WAIT_L(0); PG8_MMA(1, 0, At, B0); PG8_BAR; PG8_SCHED;
            PG8_STAGE(PG8_SB(1, 1), b3 + hstep, voffB);
            PG8_WAIT_V(6); PG8_BAR; PG8_MMA(1, 1, At, B1); PG8_BAR;
            }
        }
        if constexpr (ALIGN_EPI) { if (wr == 0) PG8_BAR; }
        if constexpr (!Epi::AFTER_DRAIN) { E(acc, cur, wr, wc, fr, fq); S.done(cur); }
        if (!has_next) break;
#pragma unroll
        for (int a = 0; a < 2; ++a)
#pragma unroll
            for (int b = 0; b < 2; ++b)
#pragma unroll
                for (int m = 0; m < 4; ++m)
#pragma unroll
                    for (int n = 0; n < 2; ++n) acc[a][b][m][n] = (f32x4){0.f, 0.f, 0.f, 0.f};
        cur = nxt; cA = nA; cB = nB; ++ui;
        if constexpr (ALIGN_EPI) { if (wr == 1) PG8_BAR; }
    }
    PG8_WAIT_V(0);
    if constexpr (!ALIGN_EPI) { if (wr == 0) PG8_BAR; }
    PG8_BAR;
    if constexpr (Epi::AFTER_DRAIN) { E.fused(acc, cur, wr, wc, fr, fq, lds, wid, lane); S.done(cur); }
#undef PG8_SA
#undef PG8_SB
#undef PG8_STAGE
#undef PG8_LDA
#undef PG8_LDB
#undef PG8_MMA
#undef PG8_WAIT_V
#undef PG8_WAIT_L
#undef PG8_BAR
#undef PG8_SCHED
}
}

#ifndef REP_P0
#define REP_P0 1
#endif
#ifndef REP_P1
#define REP_P1 1
#endif
#ifndef REP_ATT
#define REP_ATT 1
#endif
#ifndef REP_GMLP
#define REP_GMLP 1
#endif
#ifndef REP_SATT
#define REP_SATT 1
#endif
#ifndef REP_P3
#define REP_P3 1
#endif
#ifndef P1_ALIGN
#define P1_ALIGN true
#endif
#ifndef P1_SP2
#define P1_SP2 true
#endif
#ifndef REP_BAR
#define REP_BAR 1
#endif
#ifndef REP_P4
#define REP_P4 1
#endif

constexpr int NWAVES = 8;
constexpr int DM = 2048, SEQ = 8192, NSAMP = 128, MROWS = SEQ + NSAMP  , MP = 8448  , DIN = 7168, DA = 1024, NHEAD = 16, HDIM = 64;
constexpr int WBUF = 2048, TAIL0 = SEQ - 2048, PAST = 16384, NSLOT = SEQ + 4;
constexpr float EPS = 1e-6f;
constexpr float QSCALE = 0.125f * 1.4426950408889634f;
constexpr size_t OFF_YP = 0, OFF_YS = 16777216, OFF_KT = 17039360, OFF_VT = 19136512, OFF_KS = 21233664, OFF_VS = 21364736, OFF_VC = 21495808, OUT_TOTAL = 21626880;

constexpr size_t MiB = 1u << 20;
constexpr size_t WS_CTL = 0, CTL_ZERO_BYTES = 1024 * 1024;
constexpr size_t CTL_XG = 256 * 1024  , CTL_SG = 768 * 1024  ;
constexpr size_t WS_WIN = 2 * MiB, WS_WOUT = 30 * MiB, WS_XN = 38 * MiB, WS_ROPE = 71 * MiB;
constexpr int PADR = 2304;
constexpr size_t WS_Q = 74 * MiB, WS_K = 91 * MiB, WS_V = 112 * MiB, WS_GA = 133 * MiB, WS_U = 150 * MiB, WS_GV = 167 * MiB, WS_GB = 184 * MiB;
constexpr size_t WS_STATS = 201 * MiB, WS_AC = 203 * MiB, WS_SS = 236 * MiB, WS_WMP = 238 * MiB, WS_QS = 239 * MiB, WS_XB = 240 * MiB, WS_DUMMY = 241 * MiB, WS_END = 275 * MiB;
static_assert((size_t)(MP + PADR) * DA * 2 <= 21 * MiB, "K / V with padding rows");
constexpr int CW_TMO = 0, CW_BAR = 4096, CW_SEAM = 16384, CW_SEAM2 = 32768;

constexpr int LDS_BYTES = 147456;
constexpr int MISC_OFF = LDS_BYTES - 256;
constexpr int L_ACC = 0, L_ML = 256 * 64 * 2  , L_VB = L_ML + 2048  , L_END_ATT = L_VB + NWAVES * 12288;
static_assert(L_END_ATT <= MISC_OFF, "LDS map");

#ifndef TS_BLOCK
#define TS_BLOCK 0
#endif
#ifdef TS_PROBE
#define TS_MARKL(ldsbase, k) do { if (TS_PROBE == (k) && blockIdx.x == TS_BLOCK && threadIdx.x == 0) { const unsigned long long t_ = __builtin_amdgcn_s_memrealtime(); volatile __attribute__((address_space(3))) unsigned* m_ = (volatile __attribute__((address_space(3))) unsigned*)((ldsbase) + MISC_OFF + 128); m_[0] = (unsigned)t_; m_[1] = (unsigned)(t_ >> 32); } } while (0)
#else
#define TS_MARKL(ldsbase, k) do { } while (0)
#endif
#define GAS __attribute__((address_space(1)))
#define LAS __attribute__((address_space(3)))
typedef unsigned short bf16;
typedef unsigned v4u __attribute__((ext_vector_type(4)));
typedef float f32x4 __attribute__((ext_vector_type(4)));
typedef short bf16x8 __attribute__((ext_vector_type(8)));
typedef GAS unsigned gu32;
typedef GAS unsigned long long gu64;
#define RLX_AGENT __ATOMIC_RELAXED, __HIP_MEMORY_SCOPE_AGENT
#define LDS_WAIT() asm volatile("s_waitcnt lgkmcnt(0)" ::: "memory")
#define VM_WAIT() asm volatile("s_waitcnt vmcnt(0)" ::: "memory")
__device__ __forceinline__ unsigned long long rt() { return __builtin_amdgcn_s_memrealtime(); }
__device__ __forceinline__ unsigned f2bf(float f) { unsigned u = __builtin_bit_cast(unsigned, f); return (u + 0x7fffu + ((u >> 16) & 1u)) >> 16; }
__device__ __forceinline__ unsigned pk2(float lo, float hi) { return f2bf(lo) | (f2bf(hi) << 16); }
#define XB_TMO      128
#define XB_XCNT(j)  (256  + 64 * (j))
#define XB_XSUB(j)  (1280 + 64 * (j))
#define XB_XGEN(j)  (2304 + 64 * (j))
#define XB_TOP      3328
#define XB_TOPGEN   3392
#define XCD_BAR_WORDS 3456
#define XB_SPIN_CAP (1u << 18)

__device__ __forceinline__ unsigned xb_ld(unsigned* p)              { return __hip_atomic_load(p, __ATOMIC_RELAXED, __HIP_MEMORY_SCOPE_AGENT); }
__device__ __forceinline__ unsigned xb_add(unsigned* p, unsigned v) { return __hip_atomic_fetch_add(p, v, __ATOMIC_RELAXED, __HIP_MEMORY_SCOPE_AGENT); }
__device__ __forceinline__ unsigned xb_xcc_id() { return (unsigned)__builtin_amdgcn_s_getreg((3 << 11) | 20) & 0xFu; }
#define XB_SPIN(cond, bar) do { unsigned _sp = 0; while (cond) { __builtin_amdgcn_s_sleep(1); \
    if ((++_sp & 255u) == 0u) { if (xb_ld(&(bar)[XB_TMO])) break; if (_sp > XB_SPIN_CAP) { atomicAdd(&(bar)[XB_TMO], 1u); break; } } } } while (0)

struct XcdBarrier {
    unsigned* bar; unsigned x;
    volatile LAS unsigned* st;
};

__device__ __forceinline__ XcdBarrier xcd_barrier_post(unsigned* bar, volatile LAS unsigned* st) {
    XcdBarrier b; b.bar = bar; b.x = xb_xcc_id(); b.st = st;
    if (threadIdx.x == 0) (void)xb_add(&bar[XB_XCNT(b.x)], 1u);
    return b;
}
__device__ __forceinline__ void xcd_barrier_complete(unsigned* bar, unsigned x, unsigned& nloc, unsigned& nx) {
    const unsigned G = gridDim.x * gridDim.y * gridDim.z;
    unsigned sum, cnt, mine, sp = 0u;
    for (;;) {
        sum = 0u; cnt = 0u; mine = 0u;
#pragma unroll
        for (unsigned j = 0; j < 16; ++j) { const unsigned c = xb_ld(&bar[XB_XCNT(j)]); sum += c; cnt += (c > 0u) ? 1u : 0u; mine = (j == x) ? c : mine; }
        if (sum == G) break;
        __builtin_amdgcn_s_sleep(1);
        if ((++sp & 255u) == 0u) { if (xb_ld(&bar[XB_TMO])) break; if (sp > XB_SPIN_CAP) { atomicAdd(&bar[XB_TMO], 1u); break; } }
    }
    nloc = mine > 0u ? mine : 1u; nx = cnt > 0u ? cnt : 1u;
}

__device__ __forceinline__ void xcd_barrier(const XcdBarrier& b) {
    asm volatile("s_waitcnt vmcnt(0)" ::: "memory");
    __syncthreads();
    if (threadIdx.x == 0) {
        unsigned* bar = b.bar;
        __builtin_amdgcn_s_waitcnt(0);
        unsigned nloc = b.st[0], nx = b.st[1];
        if (nloc == 0u) { xcd_barrier_complete(bar, b.x, nloc, nx); b.st[0] = nloc; b.st[1] = nx; }
        const unsigned old = xb_add(&bar[XB_XSUB(b.x)], 1u);
        const unsigned gen = old / nloc;
        if (old + 1u == (gen + 1u) * nloc) {
            __builtin_amdgcn_fence(__ATOMIC_RELEASE, "agent");
            asm volatile("s_waitcnt vmcnt(0)" ::: "memory");
            const unsigned og = xb_add(&bar[XB_TOP], 1u);
            const unsigned tg = og / nx;
            if (og + 1u == (tg + 1u) * nx) xb_add(&bar[XB_TOPGEN], 1u);
            else XB_SPIN(xb_ld(&bar[XB_TOPGEN]) == tg, bar);
            __builtin_amdgcn_fence(__ATOMIC_ACQUIRE, "agent");
            xb_add(&bar[XB_XGEN(b.x)], 1u);
            asm volatile("s_waitcnt vmcnt(0)" ::: "memory");
        } else {
            XB_SPIN(xb_ld(&bar[XB_XGEN(b.x)]) == gen, bar);
            __builtin_amdgcn_fence(__ATOMIC_ACQUIRE, "agent");
            asm volatile("s_waitcnt vmcnt(0)" ::: "memory");
        }
    }
    __syncthreads();
}

struct Frame {
    LAS unsigned char* lds;
    int tid, lane, wave, vcu, G;
};
struct Args { const float* in[12]; float* out; unsigned char* ws; double invf[32]; };

typedef float f32x2v __attribute__((ext_vector_type(2)));
typedef unsigned u32x2v __attribute__((ext_vector_type(2)));
typedef short s16x4 __attribute__((ext_vector_type(4)));

__device__ __forceinline__ float wave_sum(float v) {
#pragma unroll
    for (int o = 1; o < 64; o <<= 1) v += __shfl_xor(v, o);
    return v;
}
__device__ __forceinline__ unsigned cvtpk(float lo, float hi) { return pg8::cvt_pk_bf16(lo, hi); }
__device__ __forceinline__ float bf2f(unsigned short b) { return __builtin_bit_cast(float, (unsigned)b << 16); }
__device__ __forceinline__ float bflo(unsigned w) { return __builtin_bit_cast(float, w << 16); }
__device__ __forceinline__ float bfhi(unsigned w) { return __builtin_bit_cast(float, w & 0xffff0000u); }
__device__ __forceinline__ float xsig(float x, float z) { return x * __builtin_amdgcn_rcpf(1.0f + __builtin_amdgcn_exp2f(-1.4426950408889634f * z)); }
__device__ __forceinline__ float silu_f(float x) { return xsig(x, x); }
__device__ __forceinline__ float gelu_f(float x) { return xsig(x, 1.5957691216057308f * (x + 0.044715f * x * x * x)); }

#ifdef EPI_NT
__device__ __forceinline__ void st16_wt(void* p, v4u v, bool wt) { __builtin_nontemporal_store(v, (GAS v4u*)p); }
__device__ __forceinline__ void st16_wt(void* p, f32x4 v, bool wt) { __builtin_nontemporal_store(v, (GAS f32x4*)p); }
#define ST16_DEFINED
#endif
#ifndef ST16_DEFINED
__device__ __forceinline__ void st16_wt(void* p, v4u v, bool wt) { if (wt) asm volatile("global_store_dwordx4 %0, %1, off sc1\n\ts_nop 1" :: "v"(p), "v"(v) : "memory"); else *(GAS v4u*)p = v; }
__device__ __forceinline__ void st16_wt(void* p, f32x4 v, bool wt) { if (wt) asm volatile("global_store_dwordx4 %0, %1, off sc1\n\ts_nop 1" :: "v"(p), "v"(v) : "memory"); else *(GAS f32x4*)p = v; }
#endif
__device__ __forceinline__ void st8_wt(void* p, f32x2v v, bool wt) { if (wt) asm volatile("global_store_dwordx2 %0, %1, off sc1\n\ts_nop 1" :: "v"(p), "v"(v) : "memory"); else *(GAS f32x2v*)p = v; }

#ifndef P0_PLAIN
#define P0_LD(p) __builtin_nontemporal_load(p)
#else
#define P0_LD(p) (*(p))
#endif
#ifndef F32_WT
#define F32_WT wt
#endif
#ifdef X_NT
#define X_LD(p) __builtin_nontemporal_load(p)
#else
#define X_LD(p) (*(p))
#endif
#ifndef P0_WT
#define P0_WT true
#endif
__device__ __forceinline__ void st8u_wt(GAS unsigned long long* p, unsigned long long v) { if (P0_WT) __hip_atomic_store((unsigned long long*)p, v, __ATOMIC_RELAXED, __HIP_MEMORY_SCOPE_AGENT); else *p = v; }

__device__ __forceinline__ int dest_row_in(int n) {
    if (n < 2 * DA) { const int l = n & 63, hb = n & ~63; return hb + (l < 32 ? 2 * l : 2 * (l - 32) + 1); }
    if (n < 4 * DA) return n;
    if (n < 5 * DA) { const int c = n - 4 * DA; return 4 * DA + 256 * (c >> 7) + (c & 127); }
    if (n < 6 * DA) return n + DA;
    { const int c = n - 6 * DA; return 4 * DA + 256 * (c >> 7) + 128 + (c & 127); }
}
__device__ __forceinline__ void p0_transpose_item(const float* W, int K, int N, bf16* WT, const float* gk, bool perm, LAS float* scr, int item, int lane) {
    const int nblk = N / 32, kb = item / nblk, nb = item % nblk, k0 = 64 * kb, n0 = 32 * nb;
    const int r = lane >> 3, l8 = lane & 7;
    f32x4 v[8];
#pragma unroll
    for (int i = 0; i < 8; ++i) v[i] = P0_LD((const GAS f32x4*)(W + (size_t)(k0 + 8 * i + r) * N + n0 + 4 * l8));
    if (gk) {
        float gv[8];
#pragma unroll
        for (int i = 0; i < 8; ++i) gv[i] = *((const GAS float*)gk + k0 + 8 * i + r);
#pragma unroll
        for (int i = 0; i < 8; ++i) v[i] = v[i] * gv[i];
    }
#pragma unroll
    for (int i = 0; i < 8; ++i) { LAS float* d = scr + (8 * i + r) * 33 + 4 * l8; d[0] = v[i][0]; d[1] = v[i][1]; d[2] = v[i][2]; d[3] = v[i][3]; }
    LDS_WAIT(); asm volatile("" ::: "memory");
    const int c = lane & 7;
#pragma unroll
    for (int j = 0; j < 4; ++j) { const int n = (lane >> 3) + 8 * j; const LAS float* s = scr + (8 * c) * 33 + n;
        v4u o; o.x = pk2(s[0 * 33], s[1 * 33]); o.y = pk2(s[2 * 33], s[3 * 33]); o.z = pk2(s[4 * 33], s[5 * 33]); o.w = pk2(s[6 * 33], s[7 * 33]);
        const int dr = perm ? dest_row_in(n0 + n) : (n0 + n);
        st16_wt(WT + (size_t)dr * K + k0 + 8 * c, o, P0_WT); }
    LDS_WAIT(); asm volatile("" ::: "memory");
}
__device__ __forceinline__ void rms_rows2_to_bf16(int lane, const float* xa, const float* xb, bf16* oa, bf16* ob) {
    GAS unsigned long long* o8a = (GAS unsigned long long*)oa + lane; GAS unsigned long long* o8b = (GAS unsigned long long*)ob + lane;
    f32x4 va[8], vb[8]; float sa = 0.f, sb = 0.f;
    if (xa) {
        const GAS f32x4* xr = (const GAS f32x4*)xa + lane;
#pragma unroll
        for (int j = 0; j < 8; ++j) va[j] = P0_LD(xr + 64 * j);
    } else {
#pragma unroll
        for (int j = 0; j < 8; ++j) va[j] = (f32x4){0.f, 0.f, 0.f, 0.f};
    }
    if (xb) {
        const GAS f32x4* xr = (const GAS f32x4*)xb + lane;
#pragma unroll
        for (int j = 0; j < 8; ++j) vb[j] = P0_LD(xr + 64 * j);
    } else {
#pragma unroll
        for (int j = 0; j < 8; ++j) vb[j] = (f32x4){0.f, 0.f, 0.f, 0.f};
    }
#pragma unroll
    for (int j = 0; j < 8; ++j) { sa += (va[j].x * va[j].x + va[j].y * va[j].y) + (va[j].z * va[j].z + va[j].w * va[j].w); sb += (vb[j].x * vb[j].x + vb[j].y * vb[j].y) + (vb[j].z * vb[j].z + vb[j].w * vb[j].w); }
    const float ra = 1.0f / sqrtf(wave_sum(sa) * (1.0f / DM) + EPS), rb = 1.0f / sqrtf(wave_sum(sb) * (1.0f / DM) + EPS);
#pragma unroll
    for (int j = 0; j < 8; ++j) st8u_wt(o8a + 64 * j, (unsigned long long)pk2(va[j].x * ra, va[j].y * ra) | ((unsigned long long)pk2(va[j].z * ra, va[j].w * ra) << 32));
    if (ob) {
#pragma unroll
        for (int j = 0; j < 8; ++j) st8u_wt(o8b + 64 * j, (unsigned long long)pk2(vb[j].x * rb, vb[j].y * rb) | ((unsigned long long)pk2(vb[j].z * rb, vb[j].w * rb) << 32));
    }
}
__device__ __forceinline__ void p0_prologue(const Frame& F, const Args& A) {
    unsigned char* ws = A.ws;
    LAS float* scr = (LAS float*)(F.lds + F.wave * 16384);
    const int gw = F.vcu * NWAVES + F.wave, NGW = F.G * NWAVES;
    constexpr int I_IN = (DM / 64) * (DIN / 32), I_OUT = (DM / 64) * (DM / 32);
    constexpr int NIT = I_IN + I_OUT + MP;
    for (int it = gw; it < NIT; it += NGW) {
        if (it < I_IN) p0_transpose_item(A.in[5], DM, DIN, (bf16*)(ws + WS_WIN), A.in[4], true, scr, it, F.lane);
        else if (it < I_IN + I_OUT) p0_transpose_item(A.in[10], DM, DM, (bf16*)(ws + WS_WOUT), nullptr, false, scr, it - I_IN, F.lane);
        else {
            const int m = it - (I_IN + I_OUT), m2 = (it + NGW < NIT) ? m + NGW : MP;
            const float* xa = m < SEQ ? A.in[0] + (size_t)m * DM : (m < MROWS ? A.in[1] + (size_t)(m - SEQ) * DM : nullptr);
            const float* xb = m2 < SEQ ? A.in[0] + (size_t)m2 * DM : (m2 < MROWS ? A.in[1] + (size_t)(m2 - SEQ) * DM : nullptr);
            rms_rows2_to_bf16(F.lane, xa, xb, (bf16*)(ws + WS_XN) + (size_t)m * DM, m2 < MP ? (bf16*)(ws + WS_XN) + (size_t)m2 * DM : nullptr);
            it += NGW;
        }
    }
    const int gt = gw * 64 + F.lane, NGT = NGW * 64;
    float* rope = (float*)(ws + WS_ROPE);
    for (int e = gt; e < NSLOT * 32; e += NGT) {
        const int slot = e >> 5, i = e & 31;
        const int pos = slot < SEQ ? slot : PAST + (slot - SEQ);
        const double ang = (double)pos * A.invf[i];
        const double kq = rint(ang * 0.15915494309189535);
        double r = fma(-kq, 6.283185307179586, ang); r = fma(-kq, 2.4492935982947064e-16, r);
        const float rf = (float)r;
        f32x2v cs; cs.x = cosf(rf); cs.y = sinf(rf);
        *(f32x2v*)(rope + 2 * (size_t)e) = cs;
    }
    {
        v4u z; z.x = 0u; z.y = 0u; z.z = 0u; z.w = 0u;
        for (int e = gt; e < PADR * DA / 8; e += NGT) { *(v4u*)(ws + WS_K + (size_t)e * 16) = z; *(v4u*)(ws + WS_V + (size_t)e * 16) = z; }
    }
    bf16* wmp = (bf16*)(ws + WS_WMP);
    for (int e = gt; e < 8 * 128 * 128; e += NGT) {
        const int kp = e & 127, t = (e >> 7) & 127, g = e >> 14;
        const int ss = kp >> 5, q = (kp >> 3) & 3, j = kp & 7, s = 32 * ss + 16 * (j >> 2) + 4 * q + (j & 3);
        const float w = s <= t ? A.in[8][(size_t)(g * 128 + t) * 128 + s] : 0.f;
        wmp[e] = (bf16)f2bf(w);
    }
}

struct EpiIn {
    static constexpr bool PERM = true, AFTER_DRAIN = false;
    bf16 *Q, *K, *V, *GA, *U, *GV, *GB;
    const float* rope; float* stats; float* out; float* qs; int n_units; mutable int k_done;
    __device__ __forceinline__ void operator()(const pg8::f32x4 (&acc)[2][2][4][2], const pg8::Unit& u, int wr, int wc, int fr, int fq) const {
        const int sec = u.pn >> 2;
        const int col0 = (u.pn & 3) * 256 + wc * 32 + 8 * fq;
        const int row0 = u.pm * 256 + wr * 64 + fr;
#ifdef P1_LAST_WT
        const bool wt = (++k_done == n_units);
#else
        const bool wt = false;
#endif
        if (sec <= 1) {
            bf16* dstb = sec == 0 ? Q : K;
            const float sc = sec == 0 ? QSCALE : 1.0f;
#pragma unroll
            for (int ai = 0; ai < 2; ++ai)
#pragma unroll
                for (int m = 0; m < 4; ++m) {
                    const int row = row0 + ai * 128 + m * 16;
                    const int slot = row < SEQ ? row : SEQ + ((row - SEQ) & 3);
                    float* fdst = nullptr;
                    if (sec == 1) { if (row >= TAIL0 && row < SEQ) fdst = out + OFF_KT + (size_t)(row - TAIL0) * DA; else if (row >= SEQ && row < MROWS) fdst = out + OFF_KS + (size_t)(row - SEQ) * DA; }
                    else { if (row >= SEQ && row < MROWS) fdst = qs + (size_t)(row - SEQ) * DA; }
#pragma unroll
                    for (int bj = 0; bj < 2; ++bj) {
                        const int cl = col0 + bj * 128, hb = cl & ~63, i0 = (cl & 63) >> 1;
                        const float* tp = rope + ((size_t)slot * 32 + i0) * 2;
                        const f32x4 t0 = *(const f32x4*)tp, t1 = *(const f32x4*)(tp + 4);
                        const f32x4 v0 = acc[ai][bj][m][0], v1 = acc[ai][bj][m][1];
                        f32x4 y1, y2;
                        y1[0] = (v0[0] * t0[0] - v0[1] * t0[1]) * sc; y2[0] = (v0[1] * t0[0] + v0[0] * t0[1]) * sc;
                        y1[1] = (v0[2] * t0[2] - v0[3] * t0[3]) * sc; y2[1] = (v0[3] * t0[2] + v0[2] * t0[3]) * sc;
                        y1[2] = (v1[0] * t1[0] - v1[1] * t1[1]) * sc; y2[2] = (v1[1] * t1[0] + v1[0] * t1[1]) * sc;
                        y1[3] = (v1[2] * t1[2] - v1[3] * t1[3]) * sc; y2[3] = (v1[3] * t1[2] + v1[2] * t1[3]) * sc;
                        v4u w; w.x = cvtpk(y1[0], y2[0]); w.y = cvtpk(y1[1], y2[1]); w.z = cvtpk(y1[2], y2[2]); w.w = cvtpk(y1[3], y2[3]);
                        st16_wt(dstb + (size_t)row * DA + cl, w, wt);
                        if (fdst) { st16_wt(fdst + hb + i0, y1, wt); st16_wt(fdst + hb + 32 + i0, y2, wt); }
                    }
                }
        } else if (sec == 2) {
#pragma unroll
            for (int ai = 0; ai < 2; ++ai)
#pragma unroll
                for (int m = 0; m < 4; ++m) {
                    const int row = row0 + ai * 128 + m * 16;
                    float* fdst = nullptr;
                    if (row >= TAIL0 && row < SEQ) fdst = out + OFF_VT + (size_t)(row - TAIL0) * DA; else if (row >= SEQ && row < MROWS) fdst = out + OFF_VS + (size_t)(row - SEQ) * DA;
#pragma unroll
                    for (int bj = 0; bj < 2; ++bj) {
                        const int cl = col0 + bj * 128;
                        const f32x4 v0 = acc[ai][bj][m][0], v1 = acc[ai][bj][m][1];
                        v4u w; w.x = cvtpk(v0[0], v0[1]); w.y = cvtpk(v0[2], v0[3]); w.z = cvtpk(v1[0], v1[1]); w.w = cvtpk(v1[2], v1[3]);
                        st16_wt(V + (size_t)row * DA + cl, w, wt);
                        if (fdst) { st16_wt(fdst + cl, v0, F32_WT); st16_wt(fdst + cl + 4, v1, F32_WT); }
                    }
                }
        } else if (sec == 3) {
#pragma unroll
            for (int ai = 0; ai < 2; ++ai)
#pragma unroll
                for (int m = 0; m < 4; ++m) {
                    const int row = row0 + ai * 128 + m * 16;
#pragma unroll
                    for (int bj = 0; bj < 2; ++bj) {
                        const int cl = col0 + bj * 128;
                        const f32x4 v0 = acc[ai][bj][m][0], v1 = acc[ai][bj][m][1];
                        v4u w; w.x = cvtpk(silu_f(v0[0]), silu_f(v0[1])); w.y = cvtpk(silu_f(v0[2]), silu_f(v0[3])); w.z = cvtpk(silu_f(v1[0]), silu_f(v1[1])); w.w = cvtpk(silu_f(v1[2]), silu_f(v1[3]));
                        st16_wt(GA + (size_t)row * DA + cl, w, wt);
                    }
                }
        } else if (sec <= 5) {
            const int ch0 = (u.pn - 16) * 128 + wc * 32 + 8 * fq;
#pragma unroll
            for (int ai = 0; ai < 2; ++ai)
#pragma unroll
                for (int m = 0; m < 4; ++m) {
                    const int row = row0 + ai * 128 + m * 16;
                    const f32x4 u0 = acc[ai][0][m][0], u1 = acc[ai][0][m][1], g0 = acc[ai][1][m][0], g1 = acc[ai][1][m][1];
                    v4u w; w.x = cvtpk(gelu_f(u0[0]) * silu_f(g0[0]), gelu_f(u0[1]) * silu_f(g0[1])); w.y = cvtpk(gelu_f(u0[2]) * silu_f(g0[2]), gelu_f(u0[3]) * silu_f(g0[3]));
                    w.z = cvtpk(gelu_f(u1[0]) * silu_f(g1[0]), gelu_f(u1[1]) * silu_f(g1[1])); w.w = cvtpk(gelu_f(u1[2]) * silu_f(g1[2]), gelu_f(u1[3]) * silu_f(g1[3]));
                    st16_wt(U + (size_t)row * DA + ch0, w, wt);
                }
        } else {
#pragma unroll
            for (int ai = 0; ai < 2; ++ai)
#pragma unroll
                for (int m = 0; m < 4; ++m) {
                    const int row = row0 + ai * 128 + m * 16;
                    float s1 = 0.f, s2 = 0.f;
#pragma unroll
                    for (int bj = 0; bj < 2; ++bj) {
                        const int cl = col0 + bj * 128;
                        f32x4 v0 = acc[ai][bj][m][0], v1 = acc[ai][bj][m][1];
#pragma unroll
                        for (int e = 0; e < 4; ++e) { v0[e] = gelu_f(v0[e]); v1[e] = gelu_f(v1[e]); s1 += v0[e] + v1[e]; s2 += v0[e] * v0[e] + v1[e] * v1[e]; }
                        v4u w; w.x = cvtpk(v0[0], v0[1]); w.y = cvtpk(v0[2], v0[3]); w.z = cvtpk(v1[0], v1[1]); w.w = cvtpk(v1[2], v1[3]);
                        st16_wt(GV + (size_t)row * DA + cl, w, wt);
                    }
                    s1 += __shfl_xor(s1, 16); s1 += __shfl_xor(s1, 32); s2 += __shfl_xor(s2, 16); s2 += __shfl_xor(s2, 32);
                    if (fq == 0) { f32x2v p; p.x = s1; p.y = s2; st8_wt(stats + ((size_t)row * 16 + (u.pn & 3) * 4 + wc) * 2, p, wt); }
                }
        }
    }
};


struct EpiOutFused {
    static constexpr bool PERM = false, AFTER_DRAIN = true;
    const float* xp; float* out; const float* fg; unsigned long long* xg; unsigned* tmo;
    __device__ __forceinline__ void fused(pg8::f32x4 (&acc)[2][2][4][2], const pg8::Unit& u, int wr, int wc, int fr, int fq, PG8_LAS unsigned char* lds, int wid, int lane) const {
        LAS float* P = (LAS float*)lds;
        LAS float* S = (LAS float*)(lds + 4096);
        LAS unsigned* flag = (LAS unsigned*)(lds + 5120);
        const int row0 = u.pm * 256 + wr * 64 + fr, col0 = u.pn * 256 + wc * 32 + 4 * fq;
        TS_MARKL(lds, 12);
#pragma unroll
        for (int ai = 0; ai < 2; ++ai)
#pragma unroll
            for (int m = 0; m < 4; ++m) {
                const float* xr = xp + (size_t)(row0 + ai * 128 + m * 16) * DM + col0;
                float ss = 0.f;
#pragma unroll
                for (int bj = 0; bj < 2; ++bj)
#pragma unroll
                    for (int n = 0; n < 2; ++n) {
                        const f32x4 r = X_LD((const GAS f32x4*)(xr + bj * 128 + n * 16)) + acc[ai][bj][m][n];
                        acc[ai][bj][m][n] = r;
                        ss += (r[0] * r[0] + r[1] * r[1]) + (r[2] * r[2] + r[3] * r[3]);
                    }
                ss += __shfl_xor(ss, 16); ss += __shfl_xor(ss, 32);
                if (fq == 0) P[(ai * 128 + wr * 64 + m * 16 + fr) * 4 + wc] = ss;
            }
        asm volatile("s_waitcnt lgkmcnt(0)" ::: "memory"); __builtin_amdgcn_s_barrier(); asm volatile("" ::: "memory");
        TS_MARKL(lds, 13);
        const int row = wid * 32 + (lane & 31);
        bool bad = false;
        if (lane < 32) {
            const f32x4 p = *(const LAS f32x4*)(P + row * 4);
            unsigned long long* gr = xg + ((size_t)u.pm * 256 + row) * 8;
            __hip_atomic_store(gr + u.pn, (1ull << 32) | (unsigned long long)__float_as_uint((p[0] + p[1]) + (p[2] + p[3])), __ATOMIC_RELAXED, __HIP_MEMORY_SCOPE_AGENT);
            float t = 0.f; unsigned spins = 0;
            for (;;) {
                bool ok = true; t = 0.f;
#pragma unroll
                for (int k = 0; k < 8; ++k) { const unsigned long long x = __hip_atomic_load(gr + k, __ATOMIC_RELAXED, __HIP_MEMORY_SCOPE_AGENT); ok &= (x >> 32) == 1ull; t += __uint_as_float((unsigned)x); }
                if (ok) break;
                if (++spins > (1u << 20)) { bad = true; __hip_atomic_store(tmo, 1u, __ATOMIC_RELAXED, __HIP_MEMORY_SCOPE_AGENT); break; }
                __builtin_amdgcn_s_sleep(1);
            }
            S[row] = bad ? __builtin_nanf("") : 1.0f / sqrtf(t * (1.0f / DM) + EPS);
        }
        TS_MARKL(lds, 14);
        asm volatile("s_waitcnt lgkmcnt(0)" ::: "memory"); __builtin_amdgcn_s_barrier(); asm volatile("" ::: "memory");
        TS_MARKL(lds, 16);
        f32x4 gv[2][2];
#pragma unroll
        for (int bj = 0; bj < 2; ++bj)
#pragma unroll
            for (int n = 0; n < 2; ++n) gv[bj][n] = *(const GAS f32x4*)(fg + col0 + bj * 128 + n * 16);
#pragma unroll
        for (int ai = 0; ai < 2; ++ai)
#pragma unroll
            for (int m = 0; m < 4; ++m) {
                const int rr = ai * 128 + wr * 64 + m * 16 + fr; const float rs = S[rr];
                float* orow = out + (size_t)(u.pm * 256 + rr) * DM + col0;
#pragma unroll
                for (int bj = 0; bj < 2; ++bj)
#pragma unroll
                    for (int n = 0; n < 2; ++n) {
#ifdef Y_NT
                        __builtin_nontemporal_store(acc[ai][bj][m][n] * rs * gv[bj][n], (GAS f32x4*)(orow + bj * 128 + n * 16));
#else
                        *(GAS f32x4*)(orow + bj * 128 + n * 16) = acc[ai][bj][m][n] * rs * gv[bj][n];
#endif
                    }
            }
    }
};

struct EpiOut {
    static constexpr bool PERM = false, AFTER_DRAIN = false;
    const float* xp; const float* xs; float* out; float* ssq;
    __device__ __forceinline__ void operator()(const pg8::f32x4 (&acc)[2][2][4][2], const pg8::Unit& u, int wr, int wc, int fr, int fq) const {
        const int row0 = u.pm * 256 + wr * 64 + fr, col0 = u.pn * 256 + wc * 32 + 4 * fq;
#pragma unroll
        for (int ai = 0; ai < 2; ++ai) {
            if (u.pm * 256 + ai * 128 >= MROWS) continue;
#pragma unroll
            for (int m = 0; m < 4; ++m) {
                const int row = row0 + ai * 128 + m * 16;
                const float* xr = row < SEQ ? xp + (size_t)row * DM : xs + (size_t)(row - SEQ) * DM;
                float* orow = out + (size_t)row * DM;
                float ss = 0.f;
#pragma unroll
                for (int bj = 0; bj < 2; ++bj)
#pragma unroll
                    for (int n = 0; n < 2; ++n) {
                        const int col = col0 + bj * 128 + n * 16;
                        const f32x4 r = *(const f32x4*)(xr + col) + acc[ai][bj][m][n];
                        *(f32x4*)(orow + col) = r;
                        ss += (r[0] * r[0] + r[1] * r[1]) + (r[2] * r[2] + r[3] * r[3]);
                    }
                ss += __shfl_xor(ss, 16); ss += __shfl_xor(ss, 32);
                if (fq == 0) ssq[(size_t)row * 32 + u.pn * 4 + wc] = ss;
            }
        }
    }
};

typedef short v4i16_t __attribute__((ext_vector_type(4)));
__device__ __forceinline__ s16x4 ldtr(LAS const unsigned char* p) { return __builtin_bit_cast(s16x4, __builtin_amdgcn_ds_read_tr16_b64_v4i16((LAS v4i16_t*)p)); }
#define MFMA16(a, b, c) __builtin_amdgcn_mfma_f32_16x16x32_bf16((a), (b), (c), 0, 0, 0)

struct P2Ptrs { const bf16 *Q, *K, *V, *GA, *U, *GV, *GB, *WMP; const float* stats; bf16* AC; bf16* DUMMY; const float *ck, *cv, *ksn, *vsn, *qs, *ln_g, *ln_b, *w_s, *b_s; float* vc_out; };

#ifndef AC_WT
#define AC_WT false
#endif
#ifdef P2_NT
#define P2_LD(p) __builtin_nontemporal_load(p)
#else
#define P2_LD(p) (*(p))
#endif
#define ATT_WAITV(n) asm volatile("s_waitcnt vmcnt(" #n ")" ::: "memory")
__device__ __forceinline__ void glds16(const GAS unsigned char* gsrc, unsigned lds_dst) { unsigned keep;
    asm volatile("s_mov_b32 %0, m0\n\ts_mov_b32 m0, %2\n\ts_nop 0\n\tglobal_load_lds_dwordx4 %1, off\n\ts_mov_b32 m0, %0" : "=&s"(keep) : "v"(gsrc), "s"(lds_dst) : "memory"); }
template <int VAR> __device__ __forceinline__ void attn_item(const Frame& F, const P2Ptrs& T, int h, int P0, int itc0) {
    const int lane = F.lane, w = F.wave, q16 = lane & 15, g = lane >> 4;
    LAS unsigned short* ACC = (LAS unsigned short*)(F.lds + L_ACC);
    LAS float* ML = (LAS float*)(F.lds + L_ML);
    LAS unsigned char* VB = F.lds + L_VB + w * 12288;
    const unsigned vbase = (unsigned)(uintptr_t)VB;
    const GAS unsigned char* Qh = (const GAS unsigned char*)(T.Q + h * HDIM);
    const GAS unsigned char* Kh = (const GAS unsigned char*)(T.K + (size_t)PADR * DA + h * HDIM);
    const GAS unsigned char* Vh = (const GAS unsigned char*)(T.V + (size_t)PADR * DA + h * HDIM);
    const int jr = lane >> 3, jc = (lane & 7) ^ (((lane >> 4) & 3) << 1);
    const int qq = q16 >> 2, pp = q16 & 3, fh = 2 * (g & 1) + (qq >> 1);
    int tro[4];
#pragma unroll
    for (int n = 0; n < 4; ++n) tro[n] = (4 * g + qq) * 128 + (2 * (n ^ fh) + (pp >> 1)) * 16 + 8 * (pp & 1);
    const int dq = 4 * g - q16, g4 = 4 * g;
    bf16x8 kf[20], qa0, qa1, qb0, qb1;
    qa0 = qa1 = (bf16x8){0, 0, 0, 0, 0, 0, 0, 0};
#define ATT_GEOM(it_, d_, qrb_, kb0_) const int d_ = (it_) == 0 ? 1 : ((it_) == 1 ? 4 : 16); const int sh_##d_ = (it_) == 0 ? 0 : ((it_) == 1 ? 2 : 4); (void)sh_##d_; \
        const int qrb_ = (it_) == 0 ? 32 * w + 16 : ((it_) == 1 ? (w & 3) + 128 * (w >> 2) + 64 : 2 * w + (it_) - 2); const int kb0_ = P0 + qrb_ - 144 * d_;
#define ATT_LOADK(d_, kb0_, a0_, a1_) do { const unsigned vo_ = (unsigned)((d_) * q16) * (DA * 2) + 16 * g; \
        _Pragma("unroll") for (int a = (a0_); a < (a1_); ++a) { const GAS unsigned char* kb_ = Kh + (long)((kb0_) + (d_) * 16 * a) * (DA * 2); \
            kf[2 * a] = *(const GAS bf16x8*)(kb_ + vo_); kf[2 * a + 1] = *(const GAS bf16x8*)(kb_ + vo_ + 64); } } while (0)
#define ATT_LOADQ(it_, d_, kb0_) do { const unsigned vo_ = (unsigned)((d_) * q16) * (DA * 2) + 16 * g; \
        const GAS unsigned char* qb_ = Qh + (size_t)((kb0_) + 144 * (d_)) * (DA * 2); qb0 = P2_LD((const GAS bf16x8*)(qb_ + vo_)); qb1 = P2_LD((const GAS bf16x8*)(qb_ + vo_ + 64)); \
        if ((it_) < 2) { const GAS unsigned char* qa_ = Qh + (size_t)((kb0_) + 128 * (d_)) * (DA * 2); qa0 = P2_LD((const GAS bf16x8*)(qa_ + vo_)); qa1 = P2_LD((const GAS bf16x8*)(qa_ + vo_ + 64)); } } while (0)
#define ATT_DMAV(d_, kb0_, s_, boff_) do { const unsigned vo_ = (unsigned)((d_) * jr) * (DA * 2) + 16 * jc; \
        _Pragma("unroll") for (int i = 0; i < 4; ++i) { const GAS unsigned char* vb_ = Vh + (long)((kb0_) + (d_) * (32 * (s_) + 8 * i)) * (DA * 2); \
            glds16((const GAS unsigned char*)(vb_ + vo_), (unsigned)__builtin_amdgcn_readfirstlane((int)(vbase + (boff_) + i * 1024))); } } while (0)
#define ATT_QKS(KO, Q0, Q1, KP0, LEADZ, PW, MX, LS) do { f32x4 st[9]; \
        _Pragma("unroll") for (int ti = 0; ti < 9; ++ti) { const f32x4 a_ = MFMA16(kf[(KO) + 2 * ti], Q0, ((f32x4){0.f, 0.f, 0.f, 0.f})); st[ti] = MFMA16(kf[(KO) + 2 * ti + 1], Q1, a_); } \
        _Pragma("unroll") for (int r = 0; r < 4; ++r) { if (dq < -r) st[0][r] = -INFINITY; if (dq > -r) st[8][r] = -INFINITY; } \
        if ((KP0) < 0) { const int nz_ = -((KP0) >> (4 + sh));     \
            _Pragma("unroll") for (int ti = 0; ti < 9; ++ti) if (ti < nz_) st[ti] = (f32x4){-INFINITY, -INFINITY, -INFINITY, -INFINITY}; } \
        float mx_ = -INFINITY; \
        _Pragma("unroll") for (int ti = 0; ti < 9; ++ti) mx_ = fmaxf(fmaxf(fmaxf(st[ti][0], st[ti][1]), fmaxf(st[ti][2], st[ti][3])), mx_); \
        mx_ = fmaxf(mx_, __shfl_xor(mx_, 16)); mx_ = fmaxf(mx_, __shfl_xor(mx_, 32)); \
        float ls_ = 0.f; \
        _Pragma("unroll") for (int ti = 0; ti < 9; ++ti) _Pragma("unroll") for (int r = 0; r < 4; ++r) { const float e_ = __builtin_amdgcn_exp2f(st[ti][r] - mx_); st[ti][r] = e_; ls_ += e_; } \
        ls_ += __shfl_xor(ls_, 16); ls_ += __shfl_xor(ls_, 32); MX = mx_; LS = ls_; \
        if (LEADZ) { PW[0].x = 0u; PW[0].y = 0u; PW[0].z = cvtpk(st[0][0], st[0][1]); PW[0].w = cvtpk(st[0][2], st[0][3]); \
            _Pragma("unroll") for (int s_ = 1; s_ < 5; ++s_) { PW[s_].x = cvtpk(st[2 * s_ - 1][0], st[2 * s_ - 1][1]); PW[s_].y = cvtpk(st[2 * s_ - 1][2], st[2 * s_ - 1][3]); PW[s_].z = cvtpk(st[2 * s_][0], st[2 * s_][1]); PW[s_].w = cvtpk(st[2 * s_][2], st[2 * s_][3]); } } \
        else { _Pragma("unroll") for (int s_ = 0; s_ < 4; ++s_) { PW[s_].x = cvtpk(st[2 * s_][0], st[2 * s_][1]); PW[s_].y = cvtpk(st[2 * s_][2], st[2 * s_][3]); PW[s_].z = cvtpk(st[2 * s_ + 1][0], st[2 * s_ + 1][1]); PW[s_].w = cvtpk(st[2 * s_ + 1][2], st[2 * s_ + 1][3]); } \
            PW[4].x = cvtpk(st[8][0], st[8][1]); PW[4].y = cvtpk(st[8][2], st[8][3]); PW[4].z = 0u; PW[4].w = 0u; } } while (0)
#define ATT_MERGE(O, MX, LS, QR0, p_) do { _Pragma("unroll") for (int r = 0; r < 4; ++r) { const int rho = 4 * g + r; \
            const float mp = __shfl(MX, rho), lp = __shfl(LS, rho); const int qrel = (QR0) + d * rho; \
            LAS u32x2v* apk = (LAS u32x2v*)(ACC + qrel * 64 + 4 * q16);     \
            if ((p_) == 0) { u32x2v pk_; pk_.x = cvtpk(O[0][r], O[1][r]); pk_.y = cvtpk(O[2][r], O[3][r]); *apk = pk_; if (q16 == 0) { ML[2 * qrel] = mp; ML[2 * qrel + 1] = lp; } } \
            else { const float mo = ML[2 * qrel], lo_ = ML[2 * qrel + 1]; const float mn = fmaxf(mo, mp), ao = __builtin_amdgcn_exp2f(mo - mn), ap = __builtin_amdgcn_exp2f(mp - mn), ln = lo_ * ao + lp * ap; \
                const u32x2v old_ = *apk; const float n0_ = bflo(old_.x) * ao + O[0][r] * ap, n1_ = bfhi(old_.x) * ao + O[1][r] * ap, n2_ = bflo(old_.y) * ao + O[2][r] * ap, n3_ = bfhi(old_.y) * ao + O[3][r] * ap; \
                if ((p_) == 1) { u32x2v pk_; pk_.x = cvtpk(n0_, n1_); pk_.y = cvtpk(n2_, n3_); *apk = pk_; if (q16 == 0) { ML[2 * qrel] = mn; ML[2 * qrel + 1] = ln; } } \
                else { const float inv = 1.0f / ln; LAS unsigned short* arow = ACC + qrel * 64 + q16;     \
                    arow[0] = (unsigned short)f2bf(n0_ * inv); arow[16] = (unsigned short)f2bf(n1_ * inv); arow[32] = (unsigned short)f2bf(n2_ * inv); arow[48] = (unsigned short)f2bf(n3_ * inv); } } } } while (0)
    { ATT_GEOM(0, d0, qrb0, kb00); ATT_DMAV(d0, kb00, 0, 0); ATT_DMAV(d0, kb00, 1, 4096); ATT_DMAV(d0, kb00, 2, 8192); ATT_LOADQ(0, d0, kb00); ATT_LOADK(d0, kb00, 0, 10); }
#pragma unroll 1
    for (int it = 0; it < 4; ++it) {
        ATT_GEOM(it, d, qrb, kb0);
        const int sh = sh_d;
        const bool pair = it < 2;
        v4u pwa[5], pwb[5]; float mxa = 0.f, lsa = 0.f, mxb, lsb;
        if (VAR == 2 || VAR >= 6) {
#pragma unroll
            for (int s_ = 0; s_ < 5; ++s_) { pwb[s_] = __builtin_bit_cast(v4u, kf[4 * s_]); pwa[s_] = __builtin_bit_cast(v4u, kf[4 * s_ + 1]); }
            mxb = 0.f; lsb = 1.f; mxa = 0.f; lsa = 1.f;
        } else {
        if (pair) ATT_QKS(0, qa0, qa1, kb0, false, pwa, mxa, lsa);
        ATT_QKS(2, qb0, qb1, kb0 + 16 * d, true, pwb, mxb, lsb);
        }
        __builtin_amdgcn_sched_barrier(0);
        ATT_WAITV(0);
#ifdef SATT_PF
        if (VAR == 0) {
            const int bq = F.vcu >> 3, j8 = F.vcu & 7;
            if (bq < 32)
#pragma unroll
            for (int n_ = 0; n_ < SATT_PF; ++n_) {
                const int n = (itc0 + it) * SATT_PF + n_;
                if (n < 14) {
                    const int L = ((w * 14 + n) << 6) + lane, ro = j8 * 224 + (L >> 5), isv = ro >= 896 ? 1 : 0, r = ro - 896 * isv;
                    const int idx = r < 512 ? 1536 + r : 16 * ((r - 512) >> 2) + ((r - 512) & 3);
                    const GAS unsigned char* src = (const GAS unsigned char*)(isv ? T.cv : T.ck) + ((size_t)(bq * WBUF + idx) << 12) + ((L & 31) << 7);
                    glds16(src, (unsigned)__builtin_amdgcn_readfirstlane((int)((unsigned)(uintptr_t)(F.lds + L_END_ATT) + w * 1024)));
                }
            }
        }
#endif
        ATT_GEOM(it + 1, dn, qrbn, kb0n);
        f32x4 oa[4], ob[4];
#pragma unroll
        for (int n = 0; n < 4; ++n) { oa[n] = (f32x4){0.f, 0.f, 0.f, 0.f}; ob[n] = (f32x4){0.f, 0.f, 0.f, 0.f}; }
        int gs3 = (5 * it) % 3;
#pragma unroll
        for (int s = 0; s < ((VAR == 1 || VAR == 7) ? 0 : 5); ++s) {
            if (s == 3) { if (it < 3) ATT_WAITV(8); else ATT_WAITV(4); }
            else if (s == 4) { if (it < 3) ATT_WAITV(8); else ATT_WAITV(0); }
            const int boff = gs3 * 4096;
            const bf16x8 pfa = __builtin_bit_cast(bf16x8, pwa[s]), pfb = __builtin_bit_cast(bf16x8, pwb[s]);
            LAS unsigned char* vb = VB + boff;
#pragma unroll
            for (int n2 = 0; n2 < 4; n2 += 2) {
                s16x4 lo[2], hi[2];
#pragma unroll
                for (int n = 0; n < 2; ++n) { lo[n] = ldtr(vb + tro[n2 + n]); hi[n] = ldtr(vb + tro[n2 + n] + 2048); }
                __builtin_amdgcn_sched_barrier(0);
#pragma unroll
                for (int n = 0; n < 2; ++n) {
                    const bf16x8 vf = (bf16x8){lo[n][0], lo[n][1], lo[n][2], lo[n][3], hi[n][0], hi[n][1], hi[n][2], hi[n][3]};
                    ob[n2 + n] = MFMA16(pfb, vf, ob[n2 + n]);
                    if (pair) oa[n2 + n] = MFMA16(pfa, vf, oa[n2 + n]);
                }
                __builtin_amdgcn_sched_barrier(0);
            }
            asm volatile("s_waitcnt lgkmcnt(0)" ::: "memory");
            if (s < 2) { ATT_DMAV(d, kb0, s + 3, boff); }
            else if (it < 3) { ATT_DMAV(dn, kb0n, s - 2, boff); }
            __builtin_amdgcn_sched_barrier(0);
            gs3 = gs3 == 2 ? 0 : gs3 + 1;
        }
        if (VAR == 1 || VAR == 7) {
            ATT_WAITV(0);
            if (it < 3) { ATT_DMAV(dn, kb0n, 0, 0); ATT_DMAV(dn, kb0n, 1, 4096); ATT_DMAV(dn, kb0n, 2, 8192); }
#pragma unroll
            for (int n = 0; n < 4; ++n) { ob[n] = __builtin_bit_cast(f32x4, pwb[n]); oa[n] = __builtin_bit_cast(f32x4, pwa[n]); }
        }
        if (it < 3) { ATT_LOADQ(it + 1, dn, kb0n); ATT_LOADK(dn, kb0n, 0, 10); }
        __builtin_amdgcn_sched_barrier(0);
        const int p = it < 2 ? it : 2;
        if (VAR != 3 && VAR != 6) {
        if (pair) ATT_MERGE(oa, mxa, lsa, qrb - 16 * d, p);
        ATT_MERGE(ob, mxb, lsb, qrb, p);
        } else { asm volatile("" :: "v"(oa[0]), "v"(oa[1]), "v"(oa[2]), "v"(oa[3]), "v"(ob[0]), "v"(ob[1]), "v"(ob[2]), "v"(ob[3]), "v"(mxa), "v"(lsa), "v"(mxb), "v"(lsb)); }
        if (it != 2 && VAR != 4 && VAR != 8) asm volatile("s_waitcnt lgkmcnt(0)\n\ts_barrier" ::: "memory");
    }
#undef ATT_GEOM
#undef ATT_LOADK
#undef ATT_LOADQ
#undef ATT_DMAV
#undef ATT_QKS
#undef ATT_MERGE
#pragma unroll
    for (int i = 0; i < 4; ++i) {
        const int idx = F.tid + 512 * i, qrel = idx >> 3, c8 = idx & 7;
        const v4u av = *(const LAS v4u*)(ACC + qrel * 64 + 8 * c8);
        const v4u gw = P2_LD((const GAS v4u*)(T.GA + (size_t)(P0 + qrel) * DA + h * HDIM + 8 * c8));
        v4u o; o.x = cvtpk(bflo(av.x) * bflo(gw.x), bfhi(av.x) * bfhi(gw.x)); o.y = cvtpk(bflo(av.y) * bflo(gw.y), bfhi(av.y) * bfhi(gw.y));
        o.z = cvtpk(bflo(av.z) * bflo(gw.z), bfhi(av.z) * bfhi(gw.z)); o.w = cvtpk(bflo(av.w) * bflo(gw.w), bfhi(av.w) * bfhi(gw.w));
        st16_wt((VAR ? T.DUMMY : T.AC) + (size_t)(P0 + qrel) * DM + h * HDIM + 8 * c8, o, AC_WT);
    }
    __syncthreads();
}

__device__ __forceinline__ void gmlp_item(const Frame& F, const P2Ptrs& T, int ck, int gi) {
    const int lane = F.lane, w = F.wave, q16 = lane & 15, g = lane >> 4, tid = F.tid;
    LAS unsigned char* IMG = F.lds;
    LAS f32x2v* RS = (LAS f32x2v*)(F.lds + 32768);
    LAS float* OUTB = (LAS float*)(F.lds + 36864);
    const int r0 = ck * 128, ch0 = gi * 128;
    const int c8 = tid & 15, s0 = tid >> 4;
    v4u gvr[4];
#pragma unroll
    for (int i = 0; i < 4; ++i) gvr[i] = P2_LD((const GAS v4u*)(T.GV + (size_t)(r0 + s0 + 32 * i) * DA + ch0 + 8 * c8));
    const f32x4 lg0 = *(const GAS f32x4*)(T.ln_g + ch0 + 8 * c8), lg1 = *(const GAS f32x4*)(T.ln_g + ch0 + 8 * c8 + 4);
    const f32x4 lb0 = *(const GAS f32x4*)(T.ln_b + ch0 + 8 * c8), lb1 = *(const GAS f32x4*)(T.ln_b + ch0 + 8 * c8 + 4);
    if (tid < 128) {
        const GAS float* sp = (const GAS float*)T.stats + (size_t)(r0 + tid) * 32; float s1 = 0.f, s2 = 0.f;
#pragma unroll
        for (int i = 0; i < 8; ++i) { const f32x4 v = *(const GAS f32x4*)(sp + 4 * i); s1 += v[0] + v[2]; s2 += v[1] + v[3]; }
        const float mu = s1 * (1.0f / DA), var = fmaxf(s2 * (1.0f / DA) - mu * mu, 0.f);
        f32x2v o; o.x = mu; o.y = 1.0f / sqrtf(var + EPS); RS[tid] = o;
    }
    bf16x8 af[20];
    {
        const GAS bf16* wm = (const GAS bf16*)T.WMP + (size_t)gi * 128 * 128 + (size_t)q16 * 128 + 8 * g;
        int k = 0;
#pragma unroll
        for (int tt = 0; tt < 8; ++tt)
#pragma unroll
            for (int ss = 0; ss < 4; ++ss) if (ss <= (tt >> 1)) { af[k] = *(const GAS bf16x8*)(wm + (size_t)tt * 16 * 128 + 32 * ss); ++k; }
    }
    __syncthreads();
#pragma unroll
    for (int i = 0; i < 4; ++i) {
        const int s = s0 + 32 * i;
        const f32x2v ms = RS[s];
        const v4u gv = gvr[i];
        v4u o;
        o.x = cvtpk((bflo(gv.x) - ms.x) * ms.y * lg0[0] + lb0[0], (bfhi(gv.x) - ms.x) * ms.y * lg0[1] + lb0[1]);
        o.y = cvtpk((bflo(gv.y) - ms.x) * ms.y * lg0[2] + lb0[2], (bfhi(gv.y) - ms.x) * ms.y * lg0[3] + lb0[3]);
        o.z = cvtpk((bflo(gv.z) - ms.x) * ms.y * lg1[0] + lb1[0], (bfhi(gv.z) - ms.x) * ms.y * lg1[1] + lb1[1]);
        o.w = cvtpk((bflo(gv.w) - ms.x) * ms.y * lg1[2] + lb1[2], (bfhi(gv.w) - ms.x) * ms.y * lg1[3] + lb1[3]);
        *(LAS v4u*)(IMG + (c8 >> 1) * 4096 + s * 32 + (c8 & 1) * 16) = o;
    }
    v4u ur[4]; float bs[4];
#pragma unroll
    for (int i = 0; i < 4; ++i) {
        const size_t row = (size_t)(r0 + s0 + 32 * i);
        ur[i] = P2_LD((const GAS v4u*)(T.U + row * DA + ch0 + 8 * c8));
        bs[i] = *((const GAS float*)T.b_s + gi * 128 + s0 + 32 * i);
    }
    __syncthreads();
    {
        bf16x8 bfr[4];
        const int troff = w * 4096 + (4 * g + (q16 >> 2)) * 32 + (q16 & 3) * 8;
#pragma unroll
        for (int ss = 0; ss < 4; ++ss) {
            const s16x4 lo = ldtr(IMG + troff + ss * 1024), hi = ldtr(IMG + troff + ss * 1024 + 512);
            bfr[ss] = (bf16x8){lo[0], lo[1], lo[2], lo[3], hi[0], hi[1], hi[2], hi[3]};
        }
        int k = 0;
#pragma unroll
        for (int tt = 0; tt < 8; ++tt) {
            f32x4 acc = (f32x4){0.f, 0.f, 0.f, 0.f};
#pragma unroll
            for (int ss = 0; ss < 4; ++ss) if (ss <= (tt >> 1)) { acc = MFMA16(af[k], bfr[ss], acc); ++k; }
#pragma unroll
            for (int r = 0; r < 4; ++r) OUTB[(16 * tt + 4 * g + r) * 132 + 16 * w + q16] = acc[r];
        }
    }
    __syncthreads();
#pragma unroll
    for (int i = 0; i < 4; ++i) {
        const int t = s0 + 32 * i;
        const LAS float* ob = OUTB + t * 132 + 8 * c8;
        const f32x4 m0 = *(const LAS f32x4*)ob + bs[i], m1 = *(const LAS f32x4*)(ob + 4) + bs[i];
        const v4u uv = ur[i];
        v4u o;
        o.x = cvtpk(bflo(uv.x) * m0[0], bfhi(uv.x) * m0[1]); o.y = cvtpk(bflo(uv.y) * m0[2], bfhi(uv.y) * m0[3]);
        o.z = cvtpk(bflo(uv.z) * m1[0], bfhi(uv.z) * m1[1]); o.w = cvtpk(bflo(uv.w) * m1[2], bfhi(uv.w) * m1[3]);
        st16_wt(T.AC + (size_t)(r0 + t) * DM + DA + ch0 + 8 * c8, o, AC_WT);
    }
    __syncthreads();
}

#ifdef S_NT
#define S_LD(p) __builtin_nontemporal_load(p)
#else
#define S_LD(p) (*(p))
#endif
__device__ __forceinline__ const GAS float* srow(const float* cache, const float* fresh, int b, int h, int idx) {
    return (const GAS float*)(idx >= WBUF ? fresh + ((size_t)(b * 4 + idx - WBUF) * NHEAD + h) * HDIM : cache + ((size_t)(b * WBUF + idx) * NHEAD + h) * HDIM);
}
template <int SV> __device__ __forceinline__ void sattn_item(const Frame& F, const P2Ptrs& T, int si) {
    const int lane = F.lane, ks = lane >> 4, dp = lane & 15;
    const int b = si >> 6, h = (si >> 2) & 15, t = si & 3;
    const f32x4 qv = *((const GAS f32x4*)((const GAS float*)T.qs + (size_t)(b * 4 + t) * DA + h * HDIM) + dp);
    float mx = -INFINITY, ls = 0.f;
    f32x4 o = (f32x4){0.f, 0.f, 0.f, 0.f};
#pragma unroll 1
    for (int c = 0; c < 7; ++c) {
        const int d = SV == 3 ? 1 : (SV == 4 ? 16 : (c < 2 ? 1 : (c < 4 ? 4 : 16)));
        f32x4 kv[16], vv[16];
        if (c < 6) {
#pragma unroll
            for (int ps = 0; ps < 16; ++ps) {
                const int idx = WBUF + t - (64 * (c & 1) + 4 * ps + ks) * d;
                if (SV == 5) {
                    const int idx5 = WBUF + t - (64 * (c & 1) + 4 * ps + (h & 3)) * d, h4 = h & ~3;
                    kv[ps] = *((const GAS f32x4*)srow(T.ck, T.ksn, b, h4, idx5) + lane); vv[ps] = *((const GAS f32x4*)srow(T.cv, T.vsn, b, h4, idx5) + lane);
                } else {
                kv[ps] = S_LD((const GAS f32x4*)srow(T.ck, T.ksn, b, h, idx) + dp); if (SV == 2) vv[ps] = kv[ps]; else vv[ps] = S_LD((const GAS f32x4*)srow(T.cv, T.vsn, b, h, idx) + dp);
                }
            }
        } else {
            const int dd = ks == 0 ? 1 : (ks == 1 ? 4 : 16), idx = WBUF + t - 128 * dd;
            kv[0] = *((const GAS f32x4*)srow(T.ck, T.ksn, b, h, idx) + dp); vv[0] = *((const GAS f32x4*)srow(T.cv, T.vsn, b, h, idx) + dp);
#pragma unroll
            for (int ps = 1; ps < 16; ++ps) { kv[ps] = (f32x4){0.f, 0.f, 0.f, 0.f}; vv[ps] = (f32x4){0.f, 0.f, 0.f, 0.f}; }
        }
        float sc[16]; float cm = -INFINITY;
#pragma unroll
        for (int ps = 0; ps < 16; ++ps) {
            float s = (qv[0] * kv[ps][0] + qv[1] * kv[ps][1]) + (qv[2] * kv[ps][2] + qv[3] * kv[ps][3]);
            s += __shfl_xor(s, 1); s += __shfl_xor(s, 2); s += __shfl_xor(s, 4); s += __shfl_xor(s, 8);
            if (c == 6 && (ps > 0 || ks > 2)) s = -INFINITY;
            sc[ps] = s; cm = fmaxf(cm, s);
        }
        cm = fmaxf(cm, __shfl_xor(cm, 16)); cm = fmaxf(cm, __shfl_xor(cm, 32));
        const float mn = fmaxf(mx, cm), al = __builtin_amdgcn_exp2f(mx - mn);
        mx = mn; ls *= al; o = o * al;
#pragma unroll
        for (int ps = 0; ps < 16; ++ps) { const float pe = __builtin_amdgcn_exp2f(sc[ps] - mn); ls += pe; o += vv[ps] * pe; }
    }
    ls += __shfl_xor(ls, 16); ls += __shfl_xor(ls, 32);
#pragma unroll
    for (int e = 0; e < 4; ++e) { o[e] += __shfl_xor(o[e], 16); o[e] += __shfl_xor(o[e], 32); }
    if (ks == 0) {
        const float inv = 1.0f / ls;
        const size_t row = (size_t)(SEQ + b * 4 + t);
        const int cc = h * HDIM + 4 * dp;
        const u32x2v gw = *(const GAS u32x2v*)(T.GA + row * DA + cc);
        u32x2v ov; ov.x = cvtpk(o[0] * inv * bflo(gw.x), o[1] * inv * bfhi(gw.x)); ov.y = cvtpk(o[2] * inv * bflo(gw.y), o[3] * inv * bfhi(gw.y));
        *(GAS u32x2v*)((SV ? T.DUMMY : T.AC) + row * DM + cc) = ov;
    }
}

__device__ __forceinline__ void sgmlp_item(const Frame& F, const P2Ptrs& T, int b) {
    const int lane = F.lane;
    float mu[4], rs[4];
    {
        const f32x2v pr = *(const f32x2v*)(T.stats + ((size_t)(SEQ + b * 4 + (lane >> 4)) * 16 + (lane & 15)) * 2);
        float s1 = pr.x, s2 = pr.y;
#pragma unroll
        for (int o = 1; o < 16; o <<= 1) { s1 += __shfl_xor(s1, o); s2 += __shfl_xor(s2, o); }
        const float m_ = s1 * (1.0f / DA), var = fmaxf(s2 * (1.0f / DA) - m_ * m_, 0.f), r_ = 1.0f / sqrtf(var + EPS);
#pragma unroll
        for (int t = 0; t < 4; ++t) { mu[t] = __shfl(m_, 16 * t); rs[t] = __shfl(r_, 16 * t); }
    }
#pragma unroll 1
    for (int hh = 0; hh < 2; ++hh) {
        const int ch = hh * 512 + lane * 8, gi = ch >> 7;
        float lg[8], lb[8];
#pragma unroll
        for (int e = 0; e < 8; ++e) { lg[e] = T.ln_g[ch + e]; lb[e] = T.ln_b[ch + e]; }
        float vn[4][8];
#pragma unroll
        for (int t = 0; t < 4; ++t) {
            const size_t row = (size_t)(SEQ + b * 4 + t);
            const v4u gv = *(const v4u*)(T.GV + row * DA + ch);
            const unsigned wv[4] = {gv.x, gv.y, gv.z, gv.w};
#pragma unroll
            for (int e = 0; e < 4; ++e) { vn[t][2 * e] = (bflo(wv[e]) - mu[t]) * rs[t] * lg[2 * e] + lb[2 * e]; vn[t][2 * e + 1] = (bfhi(wv[e]) - mu[t]) * rs[t] * lg[2 * e + 1] + lb[2 * e + 1]; }
            float* vo = T.vc_out + (size_t)(b * 4 + t) * DA + ch;
            *(f32x4*)vo = (f32x4){vn[t][0], vn[t][1], vn[t][2], vn[t][3]}; *(f32x4*)(vo + 4) = (f32x4){vn[t][4], vn[t][5], vn[t][6], vn[t][7]};
        }
#pragma unroll
        for (int t = 0; t < 4; ++t) {
            const size_t row = (size_t)(SEQ + b * 4 + t);
            float mix[8];
            const float bias = T.b_s[gi * 128 + t];
#pragma unroll
            for (int e = 0; e < 8; ++e) mix[e] = bias;
#pragma unroll
            for (int s = 0; s < 4; ++s) if (s <= t) { const float wts = T.w_s[(size_t)(gi * 128 + t) * 128 + s];
#pragma unroll
                for (int e = 0; e < 8; ++e) mix[e] += wts * vn[s][e]; }
            const v4u uv = *(const v4u*)(T.U + row * DA + ch);
            v4u o;
            o.x = cvtpk(bflo(uv.x) * mix[0], bfhi(uv.x) * mix[1]); o.y = cvtpk(bflo(uv.y) * mix[2], bfhi(uv.y) * mix[3]);
            o.z = cvtpk(bflo(uv.z) * mix[4], bfhi(uv.z) * mix[5]); o.w = cvtpk(bflo(uv.w) * mix[6], bfhi(uv.w) * mix[7]);
            *(v4u*)(T.AC + row * DM + DA + ch) = o;
        }
    }
}


__device__ __forceinline__ void sout_item(const Frame& F, const bf16* AC, const bf16* WoT, const float* xs, float* out, float* ssq, unsigned long long* sg, int rt, int ct) {
    const int lane = F.lane, w = F.wave, q16 = lane & 15, g = lane >> 4, tid = F.tid;
    LAS float* RED = (LAS float*)F.lds;
    const GAS unsigned char* ab = (const GAS unsigned char*)(AC + (size_t)(SEQ + 16 * rt + q16) * DM + 256 * w + 8 * g);
    const GAS unsigned char* bb = (const GAS unsigned char*)(WoT + (size_t)(64 * ct + q16) * DM + 256 * w + 8 * g);
    bf16x8 af[8];
#pragma unroll
    for (int ks = 0; ks < 8; ++ks) af[ks] = *(const GAS bf16x8*)(ab + 64 * ks);
    f32x4 acc[4];
#pragma unroll
    for (int nb = 0; nb < 4; ++nb) {
        bf16x8 bf_[8];
#pragma unroll
        for (int ks = 0; ks < 8; ++ks) bf_[ks] = *(const GAS bf16x8*)(bb + (size_t)nb * 16 * DM * 2 + 64 * ks);
        f32x4 a = (f32x4){0.f, 0.f, 0.f, 0.f};
#pragma unroll
        for (int ks = 0; ks < 8; ++ks) a = MFMA16(af[ks], bf_[ks], a);
        acc[nb] = a;
    }
#pragma unroll
    for (int nb = 0; nb < 4; ++nb)
#pragma unroll
        for (int r = 0; r < 4; ++r) RED[(w * 16 + 4 * g + r) * 64 + 16 * nb + q16] = acc[nb][r];
    __syncthreads();
    {
        const int row = tid >> 5, c2 = (tid & 31) * 2;
        float s0 = 0.f, s1 = 0.f;
#pragma unroll
        for (int ww = 0; ww < 8; ++ww) { const f32x2v v = *(const LAS f32x2v*)(RED + (ww * 16 + row) * 64 + c2); s0 += v.x; s1 += v.y; }
        const size_t grow = (size_t)(SEQ + 16 * rt + row);
        const f32x2v xr = *(const f32x2v*)(xs + (size_t)(16 * rt + row) * DM + 64 * ct + c2);
        f32x2v y; y.x = xr.x + s0; y.y = xr.y + s1;
        *(f32x2v*)(out + grow * DM + 64 * ct + c2) = y;
        float ss = y.x * y.x + y.y * y.y;
#pragma unroll
        for (int o = 1; o < 32; o <<= 1) ss += __shfl_xor(ss, o);
        if ((tid & 31) == 0) {
            if (sg) __hip_atomic_store(sg + (size_t)(16 * rt + row) * 32 + ct, (1ull << 32) | (unsigned long long)__float_as_uint(ss), __ATOMIC_RELAXED, __HIP_MEMORY_SCOPE_AGENT);
            else ssq[grow * 32 + ct] = ss;
        }
    }
    asm volatile("s_waitcnt vmcnt(0)" ::: "memory");
    __syncthreads();
}
__device__ __forceinline__ void sout_finish(const Frame& F, float* out, const unsigned long long* sg, const float* fg, unsigned* tmo, int rt, int ct) {
    const int tid = F.tid;
    const int row = tid >> 5, c2 = (tid & 31) * 2;
    const size_t grow = (size_t)(SEQ + 16 * rt + row);
    const unsigned long long* gr = sg + (size_t)(16 * rt + row) * 32 + (tid & 31);
    float t = 0.f; bool bad = false; unsigned spins = 0;
    for (;;) {
        const unsigned long long x = __hip_atomic_load(gr, __ATOMIC_RELAXED, __HIP_MEMORY_SCOPE_AGENT);
        t = __uint_as_float((unsigned)x);
        if (__all((x >> 32) == 1ull)) break;
        if (++spins > (1u << 20)) { bad = true; if (tid == 0) __hip_atomic_store(tmo, 1u, __ATOMIC_RELAXED, __HIP_MEMORY_SCOPE_AGENT); break; }
        __builtin_amdgcn_s_sleep(1);
    }
#pragma unroll
    for (int o = 1; o < 32; o <<= 1) t += __shfl_xor(t, o);
    const float rs = bad ? __builtin_nanf("") : 1.0f / sqrtf(t * (1.0f / DM) + EPS);
    float* yp = out + grow * DM + 64 * ct + c2;
    f32x2v y; y.x = __hip_atomic_load(yp, __ATOMIC_RELAXED, __HIP_MEMORY_SCOPE_AGENT); y.y = __hip_atomic_load(yp + 1, __ATOMIC_RELAXED, __HIP_MEMORY_SCOPE_AGENT);
    const f32x2v g2 = *(const f32x2v*)(fg + 64 * ct + c2);
    y.x = y.x * rs * g2.x; y.y = y.y * rs * g2.y;
    *(f32x2v*)yp = y;
}
__device__ __forceinline__ void sattn_range(const Frame& F, const P2Ptrs& T, int lo, int iw, int nw) {
#if defined(SATT_PROBE) && defined(SATT_PROBE_FIRST)
    for (int si = lo + iw; si < 2048; si += nw) sattn_item<SATT_PROBE>(F, T, si);
#endif
    for (int si = lo + iw; si < 2048; si += nw) sattn_item<0>(F, T, si);
#if defined(SATT_PROBE) && !defined(SATT_PROBE_FIRST)
    for (int si = lo + iw; si < 2048; si += nw) sattn_item<SATT_PROBE>(F, T, si);
#endif
}
__device__ __forceinline__ void p2_mixers(const Frame& F, const P2Ptrs& T, int sattn_lo, bool with_sgmlp) {
    const int gw = F.vcu * NWAVES + F.wave, NGW = F.G * NWAVES;
#ifdef P2_STAGGER
    const bool sample_first = (F.vcu & 1) != 0;
#else
    const bool sample_first = false;
#endif
    if (sample_first) {
        sattn_range(F, T, sattn_lo, gw, NGW);
        if (with_sgmlp) for (int b = gw; b < 32; b += NGW) sgmlp_item(F, T, b);
        __syncthreads();
        TS_MARKL(F.lds, 11);
    }
#ifdef ATT_ADJ
    { int itc = 0; for (int j = 0; 2 * F.vcu + j < 512 && j < 2 * ((512 + 2 * F.G - 1) / (2 * F.G)); ++j) { const int it = (2 * F.vcu + (j & 1) + (j >> 1) * 2 * F.G); if (it < 512) { attn_item<0>(F, T, it >> 5, (it & 31) * 256, itc); itc += 4; } } }
#else
    { int itc = 0; for (int it = F.vcu; it < 512; it += F.G) { attn_item<0>(F, T, it >> 5, (it & 31) * 256, itc); itc += 4; } }
#endif
#ifdef ATT_PROBE
    for (int it = F.vcu; it < 512; it += F.G) attn_item<ATT_PROBE>(F, T, it >> 5, (it & 31) * 256, 1000);
#endif
    TS_MARKL(F.lds, 9);
    for (int it = F.vcu; it < 512; it += F.G) gmlp_item(F, T, it >> 3, it & 7);
    TS_MARKL(F.lds, 10);
#if REP_GMLP > 1
    for (int it = F.vcu; it < 512; it += F.G) gmlp_item(F, T, it >> 3, it & 7);
#endif
    if (!sample_first) {
        sattn_range(F, T, sattn_lo, gw, NGW);
        if (with_sgmlp) for (int b = gw; b < 32; b += NGW) sgmlp_item(F, T, b);
    }
}

__device__ __forceinline__ void p4_final(const Frame& F, const float* yin, float* out, const float* ssq, const float* fg) {
    const int gw = F.vcu * NWAVES + F.wave, NGW = F.G * NWAVES, lane = F.lane;
    f32x4 gv[8];
#pragma unroll
    for (int j = 0; j < 8; ++j) gv[j] = *((const f32x4*)fg + 64 * j + lane);
    for (int m = gw; m < MROWS; m += NGW) {
        float s = lane < 32 ? ssq[(size_t)m * 32 + lane] : 0.f;
        s = wave_sum(s);
        const float r = 1.0f / sqrtf(s * (1.0f / DM) + EPS);
        const f32x4* yi = (const f32x4*)(yin + (size_t)m * DM) + lane; f32x4* yr = (f32x4*)(out + (size_t)m * DM) + lane;
#pragma unroll
        for (int j = 0; j < 8; ++j) { const f32x4 v = yi[64 * j]; yr[64 * j] = v * r * gv[j]; }
    }
}


__global__ void __launch_bounds__(NWAVES * 64, 2) hybrid_fwd(Args args) {
    extern __shared__ __attribute__((aligned(16))) unsigned char lds[];
    Frame F;
    F.lds = (LAS unsigned char*)lds;
    F.tid = threadIdx.x; F.lane = F.tid & 63; F.wave = __builtin_amdgcn_readfirstlane(F.tid >> 6);
    F.G = gridDim.x; { const int bx = blockIdx.x; F.vcu = (F.G % 8 == 0) ? (bx % 8) * (F.G / 8) + bx / 8 : bx; }
    unsigned char* ws = args.ws;
#ifdef Y_BUF
    float* const YPRE = (float*)(ws + WS_Y);
#else
    float* const YPRE = args.out;
#endif
    volatile LAS unsigned* MISC = (volatile LAS unsigned*)(F.lds + MISC_OFF);
    if (F.tid < 64) MISC[F.tid] = 0u;
    __syncthreads();
    XcdBarrier bar = xcd_barrier_post((unsigned*)(ws + WS_CTL) + CW_BAR, MISC + 8);
#ifdef TS_PROBE
    const unsigned long long ts0_ = __builtin_amdgcn_s_memrealtime(); unsigned long long tsx_ = ts0_;
#define TS_MARK(k) do { if (TS_PROBE == (k)) tsx_ = __builtin_amdgcn_s_memrealtime(); } while (0)
#else
#define TS_MARK(k) do { } while (0)
#endif

#ifndef SKIP_P0
    p0_prologue(F, args);
#endif
#if REP_P0 > 1
    p0_prologue(F, args);
#endif
    TS_MARK(1);
    xcd_barrier(bar);
    TS_MARK(2);
#if REP_BAR > 1
    xcd_barrier(bar);
#endif

    unsigned* ctl = (unsigned*)(ws + WS_CTL);
    const P2Ptrs T{(const bf16*)(ws + WS_Q), (const bf16*)(ws + WS_K), (const bf16*)(ws + WS_V), (const bf16*)(ws + WS_GA), (const bf16*)(ws + WS_U), (const bf16*)(ws + WS_GV), (const bf16*)(ws + WS_GB),
                   (const bf16*)(ws + WS_WMP), (const float*)(ws + WS_STATS), (bf16*)(ws + WS_AC), (bf16*)(ws + WS_DUMMY), args.in[2], args.in[3], args.out + OFF_KS, args.out + OFF_VS, (const float*)(ws + WS_QS),
                   args.in[6], args.in[7], args.in[8], args.in[9], args.out + OFF_VC};
    {
        pg8::Gemm g{(const pg8::bf16_t*)(ws + WS_XN), (const pg8::bf16_t*)(ws + WS_WIN), MP, DIN, DM};
        pg8::StaticOrder S; S.init(MP, DIN, F.G, (int)blockIdx.x);
        EpiIn E{(bf16*)(ws + WS_Q), (bf16*)(ws + WS_K) + (size_t)PADR * DA, (bf16*)(ws + WS_V) + (size_t)PADR * DA, (bf16*)(ws + WS_GA), (bf16*)(ws + WS_U), (bf16*)(ws + WS_GV), (bf16*)(ws + WS_GB),
                (const float*)(ws + WS_ROPE), (float*)(ws + WS_STATS), args.out, (float*)(ws + WS_QS), ((33 * 28 - 1 - (int)blockIdx.x) / F.G) + 1, 0};
        pg8::gemm_phase<EpiIn, pg8::StaticOrder, P1_ALIGN, P1_SP2>(F.lds, g, S, E);
    }
    TS_MARK(3);
    xcd_barrier(bar);
    TS_MARK(4);

    p2_mixers(F, T, 0, true);
    TS_MARK(5);
    xcd_barrier(bar);
    TS_MARK(6);

    if (F.G == 256) {
        const int rt = F.vcu >> 5, ct = F.vcu & 31;
        sout_item(F, (const bf16*)(ws + WS_AC), (const bf16*)(ws + WS_WOUT), args.in[1], args.out, (float*)(ws + WS_SS), (unsigned long long*)(ws + WS_CTL + CTL_SG), rt, ct);
        TS_MARKL(F.lds, 7);
        {
            pg8::Gemm g{(const pg8::bf16_t*)(ws + WS_AC), (const pg8::bf16_t*)(ws + WS_WOUT), SEQ, DM, DM};
            pg8::StaticOrder S; S.init(SEQ, DM, F.G, (int)blockIdx.x);
            EpiOutFused E{args.in[0], args.out, args.in[11], (unsigned long long*)(ws + WS_CTL + CTL_XG), ctl + CW_TMO};
            pg8::gemm_phase<EpiOutFused, pg8::StaticOrder, false, true>(F.lds, g, S, E);
        }
        TS_MARKL(F.lds, 17);
        sout_finish(F, args.out, (const unsigned long long*)(ws + WS_CTL + CTL_SG), args.in[11], ctl + CW_TMO, rt, ct);
#ifdef TS_PROBE
        TS_MARKL(F.lds, 15);
        if (blockIdx.x == TS_BLOCK && F.tid == 0) { unsigned long long tm = tsx_; if (TS_PROBE >= 9) { volatile LAS unsigned* m_ = (volatile LAS unsigned*)(F.lds + MISC_OFF + 128); tm = ((unsigned long long)m_[1] << 32) | m_[0]; }
            const unsigned long long span = tm - ts0_, te = __builtin_amdgcn_s_memrealtime(); while (__builtin_amdgcn_s_memrealtime() - te < span) __builtin_amdgcn_s_sleep(8); }
#endif
    } else {
        for (int it = F.vcu; it < 256; it += F.G) sout_item(F, (const bf16*)(ws + WS_AC), (const bf16*)(ws + WS_WOUT), args.in[1], args.out, (float*)(ws + WS_SS), (unsigned long long*)nullptr, it >> 5, it & 31);
        {
            pg8::Gemm g{(const pg8::bf16_t*)(ws + WS_AC), (const pg8::bf16_t*)(ws + WS_WOUT), SEQ, DM, DM};
            pg8::StaticOrder S; S.init(SEQ, DM, F.G, (int)blockIdx.x);
            EpiOut E{args.in[0], args.in[1], args.out, (float*)(ws + WS_SS)};
            pg8::gemm_phase<EpiOut, pg8::StaticOrder, true, true>(F.lds, g, S, E);
        }
        xcd_barrier(bar);
        p4_final(F, args.out, args.out, (const float*)(ws + WS_SS), args.in[11]);
    }
}

extern "C" void kernel_launch(void* const* d_in, const int* in_sizes, int n_in, void* d_out, int out_size, void* d_ws, size_t ws_size, hipStream_t stream) {
    static int grid = 0;
    if (grid == 0) {
        if (n_in != 12 || out_size != (int)OUT_TOTAL || ws_size < WS_END) { fprintf(stderr, "kernel_launch: unexpected shapes (n_in %d out %d ws %zu)\n", n_in, out_size, ws_size); grid = -1; return; }
        int dev = 0, cus = 0, per_cu = 0;
        if (hipGetDevice(&dev) != hipSuccess || hipDeviceGetAttribute(&cus, hipDeviceAttributeMultiprocessorCount, dev) != hipSuccess) { grid = -1; return; }
        if (hipFuncSetAttribute((const void*)hybrid_fwd, hipFuncAttributeMaxDynamicSharedMemorySize, LDS_BYTES) != hipSuccess) { fprintf(stderr, "kernel_launch: hipFuncSetAttribute failed\n"); grid = -1; return; }
        if (hipOccupancyMaxActiveBlocksPerMultiprocessor(&per_cu, (const void*)hybrid_fwd, NWAVES * 64, LDS_BYTES) != hipSuccess || per_cu < 1) { fprintf(stderr, "kernel_launch: occupancy query reports %d blocks per CU\n", per_cu); (void)hipGetLastError(); grid = -1; return; }
        grid = cus;
    }
    if (grid < 0) return;
    if (hipMemsetAsync((char*)d_ws + WS_CTL, 0, CTL_ZERO_BYTES, stream) != hipSuccess) return;
    Args a{};
    for (int i = 0; i < 12; ++i) a.in[i] = (const float*)d_in[i];
    a.out = (float*)d_out; a.ws = (unsigned char*)d_ws;
    for (int i = 0; i < 32; ++i) a.invf[i] = exp(-log(10000.0) * (double)i / 32.0);
    hipLaunchKernelGGL(hybrid_fwd, dim3(grid), dim3(NWAVES * 64), LDS_BYTES, stream, a);
}
```
